# Optimizing an MI355X kernel written in HIP

```python
import jax, jax.numpy as jnp
from jax import lax
import numpy as np

D_MODEL = 2048
BATCH = 4
SEQ = 2048
DEPTH = 2
DEC_BATCH = 128
DEC_SEQ = 8
PAST_LEN = 16384
PAGE_SIZE = 128

POOL_WIDTH = D_MODEL // 2
POOL_WINDOWS = (2, 4, 8, 16)
POOL_GROUPS = len(POOL_WINDOWS)
POOL_GROUP_DIM = POOL_WIDTH // POOL_GROUPS
POOL_BUF = max(POOL_WINDOWS) - 1
LRU_WIDTH = D_MODEL
LRU_BLOCKS = 16
LRU_BLOCK_DIM = LRU_WIDTH // LRU_BLOCKS
CONV_WIDTH = 4
CONV_BUF = CONV_WIDTH - 1
LRU_C = 8.0
IN_COLS = 2 * POOL_WIDTH + 2 * LRU_WIDTH + 2 * D_MODEL
DEEPNORM_ALPHA = (2.0 * DEPTH) ** 0.25
DEEPNORM_BETA = (8.0 * DEPTH) ** -0.25
LN_EPS = 1e-5

kernel_name = "hybrid_pool_rglru_gated_merge_step"


def _layernorm(z, g, b):
    z = z.astype(jnp.float32)
    mu = jnp.mean(z, axis=-1, keepdims=True)
    var = jnp.mean(jnp.square(z - mu), axis=-1, keepdims=True)
    return (z - mu) * lax.rsqrt(var + LN_EPS) * g + b


def _lin_combine(left, right):
    a1, b1 = left
    a2, b2 = right
    return a1 * a2, a2 * b1 + b2


def _layer(x, start, pool_buf, conv_buf, h0, w_in, b_merge, pool_w, pool_scale,
           conv_w, conv_b, lru_wa, lru_ba, lru_wx, lru_bx, lru_L,
           w_proj_a, w_proj_b, w_out, ln_g, ln_b):
    Bn, T, _ = x.shape
    f32 = jnp.float32
    proj = jnp.einsum('btd,de->bte', x, w_in)
    cuts = [POOL_WIDTH, 2 * POOL_WIDTH, 2 * POOL_WIDTH + LRU_WIDTH,
            2 * POOL_WIDTH + 2 * LRU_WIDTH, 2 * POOL_WIDTH + 2 * LRU_WIDTH + D_MODEL]
    u_a, gate_a, u_b, gate_b, m_a, m_b = jnp.split(proj, cuts, axis=-1)

    u_ext = jnp.concatenate([pool_buf.astype(u_a.dtype), u_a], axis=1)
    cs = jnp.cumsum(u_ext.astype(f32), axis=1)
    cs = jnp.pad(cs, ((0, 0), (1, 0), (0, 0)))
    pos = start + jnp.arange(T, dtype=jnp.int32)
    pooled_groups = []
    for g, w in enumerate(POOL_WINDOWS):
        lo, hi = g * POOL_GROUP_DIM, (g + 1) * POOL_GROUP_DIM
        s = (cs[:, POOL_BUF + 1:POOL_BUF + 1 + T, lo:hi]
             - cs[:, POOL_BUF + 1 - w:POOL_BUF + 1 - w + T, lo:hi])
        cnt = jnp.minimum(pos + 1, w).astype(f32)[None, :, None]
        pooled_groups.append(s / cnt)
    pooled = jnp.stack(pooled_groups, axis=2)
    diff = pooled - u_a.astype(f32).reshape(Bn, T, POOL_GROUPS, POOL_GROUP_DIM)
    mixed_a = jnp.einsum('btgc,gcd->btgd', diff, pool_w).reshape(Bn, T, POOL_WIDTH) * pool_scale
    y_a = mixed_a * jax.nn.silu(gate_a)

    xb_ext = jnp.concatenate([conv_buf.astype(u_b.dtype), u_b], axis=1)
    xc = conv_b + xb_ext[:, 0:T] * conv_w[0]
    for k in range(1, CONV_WIDTH):
        xc = xc + xb_ext[:, k:k + T] * conv_w[k]
    xcb = xc.reshape(Bn, T, LRU_BLOCKS, LRU_BLOCK_DIM)
    r = jax.nn.sigmoid(jnp.einsum('btnc,ncd->btnd', xcb, lru_wa).reshape(Bn, T, LRU_WIDTH) + lru_ba)
    i = jax.nn.sigmoid(jnp.einsum('btnc,ncd->btnd', xcb, lru_wx).reshape(Bn, T, LRU_WIDTH) + lru_bx)
    log_a = (-LRU_C * r.astype(f32)) * jax.nn.softplus(-lru_L.astype(f32))
    a = jnp.exp(log_a)
    b = jnp.sqrt(-jnp.expm1(2.0 * log_a)) * (i * xc).astype(f32)
    b = b.at[:, 0].add(a[:, 0] * h0.astype(f32))
    _, h = lax.associative_scan(_lin_combine, (a, b), axis=1)
    y_b = h * jax.nn.silu(gate_b)

    g_a = jax.nn.sigmoid(m_a + b_merge[0])
    g_b = jax.nn.sigmoid(m_b + b_merge[1])
    merged = (g_a * jnp.einsum('btc,cd->btd', y_a, w_proj_a)
              + g_b * jnp.einsum('btc,cd->btd', y_b, w_proj_b))
    out = jnp.einsum('btd,de->bte', merged, w_out)
    y = _layernorm(DEEPNORM_ALPHA * x.astype(f32) + out.astype(f32), ln_g, ln_b)
    return (y.astype(x.dtype), u_ext[:, -POOL_BUF:], xb_ext[:, -CONV_BUF:], h[:, -1])


def setup_inputs(seed: int = 0) -> dict:
    key = jax.random.key(seed)
    ks = jax.random.split(key, 24)
    nrm = lambda k, shape, s: jax.random.normal(k, shape, jnp.float32) * s
    a_base = jax.random.uniform(ks[14], (DEPTH, LRU_WIDTH), jnp.float32, 0.9, 0.999)
    sig = a_base ** (1.0 / LRU_C)
    lru_L = jnp.log(sig) - jnp.log1p(-sig)
    return {
        "x_prompt": nrm(ks[0], (BATCH, SEQ, D_MODEL), 1.0),
        "x_sample": nrm(ks[1], (DEC_BATCH, DEC_SEQ, D_MODEL), 1.0),
        "state_pool": nrm(ks[2], (DEPTH, DEC_BATCH, POOL_BUF, POOL_WIDTH), 1.0),
        "state_conv": nrm(ks[3], (DEPTH, DEC_BATCH, CONV_BUF, LRU_WIDTH), 1.0),
        "state_h": nrm(ks[4], (DEPTH, DEC_BATCH, LRU_WIDTH), 0.5),
        "w_in": nrm(ks[5], (DEPTH, D_MODEL, IN_COLS), D_MODEL ** -0.5),
        "b_merge": nrm(ks[6], (DEPTH, 2, D_MODEL), 0.02),
        "pool_w": nrm(ks[7], (DEPTH, POOL_GROUPS, POOL_GROUP_DIM, POOL_GROUP_DIM), POOL_GROUP_DIM ** -0.5),
        "pool_scale": 1.0 + nrm(ks[8], (DEPTH, POOL_WIDTH), 0.1),
        "conv_w": nrm(ks[9], (DEPTH, CONV_WIDTH, LRU_WIDTH), CONV_WIDTH ** -0.5),
        "conv_b": nrm(ks[10], (DEPTH, LRU_WIDTH), 0.02),
        "lru_wa": nrm(ks[11], (DEPTH, LRU_BLOCKS, LRU_BLOCK_DIM, LRU_BLOCK_DIM), LRU_BLOCK_DIM ** -0.5),
        "lru_ba": nrm(ks[12], (DEPTH, LRU_WIDTH), 0.02),
        "lru_wx": nrm(ks[13], (DEPTH, LRU_BLOCKS, LRU_BLOCK_DIM, LRU_BLOCK_DIM), LRU_BLOCK_DIM ** -0.5),
        "lru_bx": nrm(ks[15], (DEPTH, LRU_WIDTH), 0.02),
        "lru_L": lru_L,
        "w_proj_a": nrm(ks[16], (DEPTH, POOL_WIDTH, D_MODEL), DEEPNORM_BETA * POOL_WIDTH ** -0.5),
        "w_proj_b": nrm(ks[17], (DEPTH, LRU_WIDTH, D_MODEL), DEEPNORM_BETA * LRU_WIDTH ** -0.5),
        "w_out": nrm(ks[18], (DEPTH, D_MODEL, D_MODEL), DEEPNORM_BETA * D_MODEL ** -0.5),
        "ln_g": 1.0 + nrm(ks[19], (DEPTH, D_MODEL), 0.02),
        "ln_b": nrm(ks[20], (DEPTH, D_MODEL), 0.02),
    }


def reference(x_prompt, x_sample, state_pool, state_conv, state_h,
              w_in, b_merge, pool_w, pool_scale, conv_w, conv_b,
              lru_wa, lru_ba, lru_wx, lru_bx, lru_L,
              w_proj_a, w_proj_b, w_out, ln_g, ln_b):
    Bp = x_prompt.shape[0]
    yp, ys = x_prompt, x_sample
    pool_p, conv_p, h_p, pool_s, conv_s, h_s = [], [], [], [], [], []
    zero_pool = jnp.zeros((Bp, POOL_BUF, POOL_WIDTH), x_prompt.dtype)
    zero_conv = jnp.zeros((Bp, CONV_BUF, LRU_WIDTH), x_prompt.dtype)
    zero_h = jnp.zeros((Bp, LRU_WIDTH), jnp.float32)
    for l in range(DEPTH):
        params = (w_in[l], b_merge[l], pool_w[l], pool_scale[l], conv_w[l], conv_b[l],
                  lru_wa[l], lru_ba[l], lru_wx[l], lru_bx[l], lru_L[l],
                  w_proj_a[l], w_proj_b[l], w_out[l], ln_g[l], ln_b[l])
        yp, pb, cb, hl = _layer(yp, 0, zero_pool, zero_conv, zero_h, *params)
        pool_p.append(pb); conv_p.append(cb); h_p.append(hl)
        ys, pb, cb, hl = _layer(ys, PAST_LEN, state_pool[l], state_conv[l], state_h[l], *params)
        pool_s.append(pb); conv_s.append(cb); h_s.append(hl)
    return (yp, ys,
            jnp.stack(pool_p), jnp.stack(conv_p), jnp.stack(h_p),
            jnp.stack(pool_s), jnp.stack(conv_s), jnp.stack(h_s))
```

```cpp
#include <hip/hip_runtime.h>
#include <hip/hip_cooperative_groups.h>
#include <cstdio>
#include <cstdint>
namespace cg = cooperative_groups;

namespace pg8 {
#define PG8_LAS __attribute__((address_space(3)))
typedef unsigned short bf16_t;
typedef short bf16x8 __attribute__((ext_vector_type(8)));
typedef float f32x4 __attribute__((ext_vector_type(4)));
typedef unsigned u32x4 __attribute__((ext_vector_type(4)));
constexpr int BM = 256, BK = 64, HALF = 128, HTB = HALF * BK * 2  , STAGE_BYTES = 8 * HTB, NXCD = 8, WGM = 8;

__host__ __device__ __forceinline__ int lds_byte(int r, int c) { const int st = (r >> 4) * 2 + (c >> 5), rr = r & 15, cc = c & 31, ob = rr * 64 + cc * 2; return st * 1024 + (ob ^ (((ob >> 9) & 1) << 5)); }
__host__ __device__ __forceinline__ void stage_rc(int b, int& R, int& C) { const int st = b / 1024, sb = b % 1024, swz = sb ^ (((sb >> 9) & 1) << 5); R = (st >> 1) * 16 + swz / 64; C = (st & 1) * 32 + (swz % 64) / 2; }
__host__ __device__ __forceinline__ int perm32(int rho) { const int n = rho >> 4, i = rho & 15; return 8 * (i >> 2) + 4 * n + (i & 3); }

struct Unit { int pm, pn; };
struct Gemm { const bf16_t* A; const bf16_t* Bt; int M, N, K, ld; };

struct StaticOrder {
    int nM, nN, nwg, G, c;
    __host__ __device__ void init(int M, int N, int G_, int c_) { nM = M / BM; nN = N / BM; nwg = nM * nN; G = G_; c = c_; }
    __host__ __device__ bool next(int i, Unit& u) const {
        const long L = (long)i * G + c; if (L >= nwg) return false;
        int wgid = (int)L; { const int q = nwg / NXCD, r = nwg % NXCD, xcd = wgid % NXCD, off = wgid / NXCD; wgid = (xcd < r ? xcd * (q + 1) : r * (q + 1) + (xcd - r) * q) + off; }
        const int nig = WGM * nN, gid = wgid / nig, fm = gid * WGM, gsz = (nM - fm) < WGM ? (nM - fm) : WGM;
        u.pm = fm + ((wgid % nig) % gsz); u.pn = (wgid % nig) / gsz; return true;
    }
    __device__ __forceinline__ void a_ready(const Unit&) const {}
    __device__ __forceinline__ void done(const Unit&) const {}
};
__device__ __forceinline__ unsigned cvt_pk_bf16(float lo, float hi) { unsigned r; asm volatile("v_cvt_pk_bf16_f32 %0, %1, %2" : "=v"(r) : "v"(lo), "v"(hi)); return r; }
typedef unsigned u32x2 __attribute__((ext_vector_type(2)));
__device__ __forceinline__ float fast_sigmoid(float v) { return __builtin_amdgcn_rcpf(1.0f + __expf(-v)); }
struct EpiProj {
    static constexpr bool PERM = true, AFTER_DRAIN = false, HOOK = false;
    bf16_t* O; int ldc; const float* bmerge;
    __device__ __forceinline__ void operator()(const f32x4 (&acc)[2][2][4][2], const Unit& u, int wr, int wc, int fr, int fq) const {
        const int row0 = u.pm * BM + wr * 64 + fr; const int col0 = u.pn * BM + wc * 32 + 8 * fq;
        const int mode = (u.pn >= 24) ? 2 : (((u.pn >= 4 && u.pn < 8) || (u.pn >= 16)) ? 1 : 0);
        f32x4 bv[2][2];
#pragma unroll
        for (int bj = 0; bj < 2; ++bj)
#pragma unroll
            for (int n = 0; n < 2; ++n) bv[bj][n] = (mode == 2) ? *(const f32x4*)(bmerge + (col0 - 6144) + bj * HALF + 4 * n) : (f32x4){0.f, 0.f, 0.f, 0.f};
#pragma unroll
        for (int ai = 0; ai < 2; ++ai)
#pragma unroll
            for (int m = 0; m < 4; ++m) { bf16_t* rowp = O + (size_t)(row0 + ai * HALF + m * 16) * ldc + col0;
#pragma unroll
                for (int bj = 0; bj < 2; ++bj) { f32x4 v0 = acc[ai][bj][m][0] + bv[bj][0], v1 = acc[ai][bj][m][1] + bv[bj][1];
                    if (mode == 1) {
#pragma unroll
                        for (int j = 0; j < 4; ++j) { v0[j] = v0[j] * fast_sigmoid(v0[j]); v1[j] = v1[j] * fast_sigmoid(v1[j]); } }
                    else if (mode == 2) {
#pragma unroll
                        for (int j = 0; j < 4; ++j) { v0[j] = fast_sigmoid(v0[j]); v1[j] = fast_sigmoid(v1[j]); } }
                    u32x4 w; w.x = cvt_pk_bf16(v0[0], v0[1]); w.y = cvt_pk_bf16(v0[2], v0[3]); w.z = cvt_pk_bf16(v1[0], v1[1]); w.w = cvt_pk_bf16(v1[2], v1[3]);
                    *(u32x4*)(rowp + bj * HALF) = w; } }
    }
};
__device__ __forceinline__ void unpack_bf16x8(const u32x4 w, f32x4& lo, f32x4& hi) {
    lo[0] = __uint_as_float(w.x << 16); lo[1] = __uint_as_float(w.x & 0xffff0000u); lo[2] = __uint_as_float(w.y << 16); lo[3] = __uint_as_float(w.y & 0xffff0000u);
    hi[0] = __uint_as_float(w.z << 16); hi[1] = __uint_as_float(w.z & 0xffff0000u); hi[2] = __uint_as_float(w.w << 16); hi[3] = __uint_as_float(w.w & 0xffff0000u);
}
struct EpiMergeA {
    static constexpr bool PERM = true, AFTER_DRAIN = false, HOOK = false;
    float* T; const bf16_t* G; int ldg; int gcol0;
    __device__ __forceinline__ void operator()(const f32x4 (&acc)[2][2][4][2], const Unit& u, int wr, int wc, int fr, int fq) const {
        const int row0 = u.pm * BM + wr * 64 + fr; const int col0 = u.pn * BM + wc * 32 + 8 * fq;
#pragma unroll
        for (int ai = 0; ai < 2; ++ai)
#pragma unroll
            for (int m = 0; m < 4; ++m) { const size_t row = (size_t)(row0 + ai * HALF + m * 16);
#pragma unroll
                for (int bj = 0; bj < 2; ++bj) { const u32x4 gw = *(const u32x4*)(G + row * ldg + gcol0 + col0 + bj * HALF); f32x4 g0, g1; unpack_bf16x8(gw, g0, g1);
                    float* tp = T + row * 2048 + col0 + bj * HALF;
                    *(f32x4*)tp = acc[ai][bj][m][0] * g0; *(f32x4*)(tp + 4) = acc[ai][bj][m][1] * g1; }
                asm volatile("" ::: "memory"); }
    }
};
struct EpiMergeB {
    static constexpr bool PERM = true, AFTER_DRAIN = false, HOOK = false;
    const float* T; bf16_t* O; const bf16_t* G; int ldg; int gcol0;
    __device__ __forceinline__ void operator()(const f32x4 (&acc)[2][2][4][2], const Unit& u, int wr, int wc, int fr, int fq) const {
        const int row0 = u.pm * BM + wr * 64 + fr; const int col0 = u.pn * BM + wc * 32 + 8 * fq;
#pragma unroll
        for (int ai = 0; ai < 2; ++ai)
#pragma unroll
            for (int m = 0; m < 4; ++m) { const size_t row = (size_t)(row0 + ai * HALF + m * 16);
#pragma unroll
                for (int bj = 0; bj < 2; ++bj) { const u32x4 gw = *(const u32x4*)(G + row * ldg + gcol0 + col0 + bj * HALF); f32x4 g0, g1; unpack_bf16x8(gw, g0, g1);
                    const float* tp = T + row * 2048 + col0 + bj * HALF;
                    const f32x4 v0 = *(const f32x4*)tp + acc[ai][bj][m][0] * g0, v1 = *(const f32x4*)(tp + 4) + acc[ai][bj][m][1] * g1;
                    u32x4 w; w.x = cvt_pk_bf16(v0[0], v0[1]); w.y = cvt_pk_bf16(v0[2], v0[3]); w.z = cvt_pk_bf16(v1[0], v1[1]); w.w = cvt_pk_bf16(v1[2], v1[3]);
                    *(u32x4*)(O + row * 2048 + col0 + bj * HALF) = w; }
                asm volatile("" ::: "memory"); }
    }
};
struct EpiOut {
    static constexpr bool PERM = false, AFTER_DRAIN = false, HOOK = false;
    const float* xp; const float* xs; float* Z; float alpha;
    __device__ __forceinline__ void operator()(const f32x4 (&acc)[2][2][4][2], const Unit& u, int wr, int wc, int fr, int fq) const {
        const int row0 = u.pm * BM + wr * 64 + fr, col0 = u.pn * BM + wc * 32 + 4 * fq;
        const float* xb = (u.pm < 32) ? xp : (xs - (size_t)8192 * 2048);
#pragma unroll
        for (int ai = 0; ai < 2; ++ai)
#pragma unroll
            for (int m = 0; m < 4; ++m) { const size_t off = (size_t)(row0 + ai * HALF + m * 16) * 2048 + col0;
#pragma unroll
                for (int bj = 0; bj < 2; ++bj)
#pragma unroll
                    for (int n = 0; n < 2; ++n) { const f32x4 xv = *(const f32x4*)(xb + off + bj * HALF + n * 16);
                        *(f32x4*)(Z + off + bj * HALF + n * 16) = xv * alpha + acc[ai][bj][m][n]; }
                asm volatile("" ::: "memory"); }
    }
};
struct EpiMerge {
    static constexpr bool PERM = true, AFTER_DRAIN = false, HOOK = true;
    bf16_t* O; const bf16_t* G; int ldg; int hook_t; int raw;
    __device__ __forceinline__ void hook(f32x4 (&acc)[2][2][4][2], const Unit& u, int wr, int wc, int fr, int fq) const {
        int row0 = u.pm * BM + wr * 64 + fr, col0 = u.pn * BM + wc * 32 + 8 * fq;
        asm volatile("" : "+v"(row0), "+v"(col0));
        u32x4 ga[4][2], gb[4][2];
#pragma unroll
        for (int g = 0; g < 3; ++g)
#pragma unroll
            for (int bj = 0; bj < 2; ++bj) { const bf16_t* gp = G + (size_t)(row0 + (g >> 2) * HALF + (g & 3) * 16) * ldg + col0 + bj * HALF; ga[g][bj] = *(const u32x4*)(gp + 6144); gb[g][bj] = *(const u32x4*)(gp + 8192); }
#pragma unroll
        for (int g = 0; g < 8; ++g) { const int ai = g >> 2, m = g & 3, cb = g & 3;
            if (g + 3 < 8) { const int gn = g + 3, an = gn >> 2, mn = gn & 3, nb_ = gn & 3;
#pragma unroll
                for (int bj = 0; bj < 2; ++bj) { const bf16_t* gp = G + (size_t)(row0 + an * HALF + mn * 16) * ldg + col0 + bj * HALF; ga[nb_][bj] = *(const u32x4*)(gp + 6144); gb[nb_][bj] = *(const u32x4*)(gp + 8192); } }
#pragma unroll
            for (int bj = 0; bj < 2; ++bj) { f32x4 a0, a1, b0, b1; unpack_bf16x8(ga[cb][bj], a0, a1); unpack_bf16x8(gb[cb][bj], b0, b1);
#pragma unroll
                for (int j = 0; j < 4; ++j) { a0[j] = a0[j] * __builtin_amdgcn_rcpf(fmaxf(b0[j], 1e-30f)); a1[j] = a1[j] * __builtin_amdgcn_rcpf(fmaxf(b1[j], 1e-30f)); }
                acc[ai][bj][m][0] = acc[ai][bj][m][0] * a0; acc[ai][bj][m][1] = acc[ai][bj][m][1] * a1; }
            asm volatile("" ::: "memory"); }
    }
    __device__ __forceinline__ void operator()(const f32x4 (&acc)[2][2][4][2], const Unit& u, int wr, int wc, int fr, int fq) const {
        const int row0 = u.pm * BM + wr * 64 + fr; const int col0 = u.pn * BM + wc * 32 + 8 * fq;
        if (raw) {
#pragma unroll
            for (int ai = 0; ai < 2; ++ai)
#pragma unroll
                for (int m = 0; m < 4; ++m)
#pragma unroll
                    for (int bj = 0; bj < 2; ++bj) { const f32x4 v0 = acc[ai][bj][m][0], v1 = acc[ai][bj][m][1];
                        u32x4 w; w.x = cvt_pk_bf16(v0[0], v0[1]); w.y = cvt_pk_bf16(v0[2], v0[3]); w.z = cvt_pk_bf16(v1[0], v1[1]); w.w = cvt_pk_bf16(v1[2], v1[3]);
                        *(u32x4*)(O + (size_t)(row0 + ai * HALF + m * 16) * 2048 + col0 + bj * HALF) = w; }
            return;
        }
        u32x4 gb[8][2];
#pragma unroll
        for (int g = 0; g < 8; ++g)
#pragma unroll
            for (int bj = 0; bj < 2; ++bj) gb[g][bj] = *(const u32x4*)(G + (size_t)(row0 + (g >> 2) * HALF + (g & 3) * 16) * ldg + 8192 + col0 + bj * HALF);
#pragma unroll
        for (int g = 0; g < 8; ++g) { const int ai = g >> 2, m = g & 3; const size_t row = (size_t)(row0 + ai * HALF + m * 16);
#pragma unroll
            for (int bj = 0; bj < 2; ++bj) { f32x4 b0, b1; unpack_bf16x8(gb[g][bj], b0, b1);
#pragma unroll
                for (int j = 0; j < 4; ++j) { b0[j] = fmaxf(b0[j], 1e-30f); b1[j] = fmaxf(b1[j], 1e-30f); }
                const f32x4 v0 = acc[ai][bj][m][0] * b0, v1 = acc[ai][bj][m][1] * b1;
                u32x4 w; w.x = cvt_pk_bf16(v0[0], v0[1]); w.y = cvt_pk_bf16(v0[2], v0[3]); w.z = cvt_pk_bf16(v1[0], v1[1]); w.w = cvt_pk_bf16(v1[2], v1[3]);
                *(u32x4*)(O + row * 2048 + col0 + bj * HALF) = w; } }
    }
};
struct EpiOutB {
    static constexpr bool PERM = true, AFTER_DRAIN = false, HOOK = false;
    bf16_t* O;
    __device__ __forceinline__ void operator()(const f32x4 (&acc)[2][2][4][2], const Unit& u, int wr, int wc, int fr, int fq) const {
        const int row0 = u.pm * BM + wr * 64 + fr; const int col0 = u.pn * BM + wc * 32 + 8 * fq;
#pragma unroll
        for (int ai = 0; ai < 2; ++ai)
#pragma unroll
            for (int m = 0; m < 4; ++m) { bf16_t* rowp = O + (size_t)(row0 + ai * HALF + m * 16) * 2048 + col0;
#pragma unroll
                for (int bj = 0; bj < 2; ++bj) { const f32x4 v0 = acc[ai][bj][m][0], v1 = acc[ai][bj][m][1];
                    u32x4 w; w.x = cvt_pk_bf16(v0[0], v0[1]); w.y = cvt_pk_bf16(v0[2], v0[3]); w.z = cvt_pk_bf16(v1[0], v1[1]); w.w = cvt_pk_bf16(v1[2], v1[3]);
                    *(u32x4*)(rowp + bj * HALF) = w; } }
    }
};
template <class Epi, class Sched, bool ALIGN_EPI = false, bool SP2 = false>
__device__ __forceinline__ void gemm_phase(PG8_LAS unsigned char* lds, const Gemm g, const Sched& S, const Epi& E) {
    int tid_ = threadIdx.x; asm volatile("" : "+v"(tid_)); const int tid = tid_, wid = __builtin_amdgcn_readfirstlane(tid >> 6), lane = tid & 63, wr = wid >> 2, wc = wid & 3, fr = lane & 15, fq = lane >> 4;
    const int K = g.ld, nt = g.K / BK;
    unsigned voffA[2], voffB[2];
#pragma unroll
    for (int i = 0; i < 2; ++i) { int R, C; stage_rc(tid * 16 + i * 8192, R, C); const int Rb = Epi::PERM ? ((R & ~31) + perm32(R & 31)) : R;
        voffA[i] = (unsigned)(R * K + C) * 2u; voffB[i] = (unsigned)(Rb * K + C) * 2u; }
    const size_t kstep = (size_t)(BK * 2);
    const size_t hstep = (size_t)HALF * K * 2;
    const size_t tstep = 2 * hstep;
    const unsigned ldsw = (unsigned)wid * 1024u;
    const int aoff = lds_byte(wr * 64 + fr, fq * 8), boff = lds_byte(wc * 32 + fr, fq * 8);
#define PG8_SA(b, h) (((b) * 2 + (h)) * HTB)
#define PG8_SB(b, h) ((4 + (b) * 2 + (h)) * HTB)
#define PG8_STAGE(bufoff, gbase, voff) do { _Pragma("unroll") for (int _i = 0; _i < 2; ++_i) \
        __builtin_amdgcn_global_load_lds((const unsigned*)((const char*)(gbase) + (voff)[_i]), (PG8_LAS unsigned*)(lds + (bufoff) + ldsw + _i * 8192), 16, 0, 0); } while (0)
#define PG8_LDA(dst, b, h) do { _Pragma("unroll") for (int m = 0; m < 4; ++m) _Pragma("unroll") for (int k = 0; k < 2; ++k) dst[m][k] = *(const PG8_LAS bf16x8*)(lds + PG8_SA(b, h) + aoff + m * 2048 + k * 1024); } while (0)
#define PG8_LDB(dst, b, h) do { _Pragma("unroll") for (int n = 0; n < 2; ++n) _Pragma("unroll") for (int k = 0; k < 2; ++k) dst[n][k] = *(const PG8_LAS bf16x8*)(lds + PG8_SB(b, h) + boff + n * 2048 + k * 1024); } while (0)
#define PG8_MMA(ai, bj, At, Bt) do { __builtin_amdgcn_s_setprio(1); _Pragma("unroll") for (int m = 0; m < 4; ++m) _Pragma("unroll") for (int n = 0; n < 2; ++n) _Pragma("unroll") for (int k = 0; k < 2; ++k) \
        acc[ai][bj][m][n] = __builtin_amdgcn_mfma_f32_16x16x32_bf16(Bt[n][k], At[m][k], acc[ai][bj][m][n], 0, 0, 0); __builtin_amdgcn_s_setprio(0); } while (0)
#define PG8_WAIT_V(n) asm volatile("s_waitcnt vmcnt(" #n ")" ::: "memory")
#define PG8_WAIT_L(n) asm volatile("s_waitcnt lgkmcnt(" #n ")" ::: "memory")
#define PG8_BAR __builtin_amdgcn_s_barrier()
#define PG8_SCHED __builtin_amdgcn_sched_barrier(0)
    Unit cur, nxt; int ui = 0;
    if (!S.next(0, cur)) return;
    f32x4 acc[2][2][4][2];
#pragma unroll
    for (int a = 0; a < 2; ++a)
#pragma unroll
        for (int b = 0; b < 2; ++b)
#pragma unroll
            for (int m = 0; m < 4; ++m)
#pragma unroll
                for (int n = 0; n < 2; ++n) acc[a][b][m][n] = (f32x4){0.f, 0.f, 0.f, 0.f};
    bf16x8 At[4][2], B0[2][2], B1[2][2];
    const char* cA = (const char*)g.A + (size_t)cur.pm * tstep; const char* cB = (const char*)g.Bt + (size_t)cur.pn * tstep;
    S.a_ready(cur);
    if constexpr (SP2) {
        PG8_STAGE(PG8_SB(0, 0), cB, voffB); PG8_STAGE(PG8_SB(0, 1), cB + hstep, voffB); PG8_STAGE(PG8_SA(0, 0), cA, voffA); PG8_STAGE(PG8_SA(0, 1), cA + hstep, voffA);
        if (wr == 1) PG8_BAR;
        PG8_WAIT_V(2); PG8_BAR;
        PG8_STAGE(PG8_SB(1, 0), cB + kstep, voffB); PG8_STAGE(PG8_SA(1, 0), cA + kstep, voffA); PG8_STAGE(PG8_SB(1, 1), cB + hstep + kstep, voffB);
        PG8_WAIT_V(6); PG8_BAR;
    } else {
        PG8_STAGE(PG8_SB(0, 0), cB, voffB); PG8_STAGE(PG8_SA(0, 0), cA, voffA); PG8_STAGE(PG8_SB(0, 1), cB + hstep, voffB); PG8_STAGE(PG8_SA(0, 1), cA + hstep, voffA);
        if (wr == 1) PG8_BAR;
        PG8_WAIT_V(4); PG8_BAR;
        PG8_STAGE(PG8_SB(1, 0), cB + kstep, voffB); PG8_STAGE(PG8_SA(1, 0), cA + kstep, voffA); PG8_STAGE(PG8_SB(1, 1), cB + hstep + kstep, voffB);
        PG8_WAIT_V(6); PG8_BAR;
    }
    for (;;) {
        const bool has_next = S.next(ui + 1, nxt);
        const char* nA = has_next ? (const char*)g.A + (size_t)nxt.pm * tstep : cA; const char* nB = has_next ? (const char*)g.Bt + (size_t)nxt.pn * tstep : cB;
        for (int t = 0; t < nt; t += 2) {
            if constexpr (Epi::HOOK) { if (t == E.hook_t) E.hook(acc, cur, wr, wc, fr, fq); }
            const bool last = (t == nt - 2);
            const char* a1 = cA + (size_t)(t + 1) * kstep;
            const char* a2 = last ? nA : cA + (size_t)(t + 2) * kstep; const char* b2 = last ? nB : cB + (size_t)(t + 2) * kstep;
            const char* a3 = a2 + kstep; const char* b3 = b2 + kstep;
            if (last && has_next) S.a_ready(nxt);
            if constexpr (SP2) {
            PG8_LDB(B0, 0, 0); PG8_LDB(B1, 0, 1); PG8_SCHED; PG8_LDA(At, 0, 0); PG8_STAGE(PG8_SA(1, 1), a1 + hstep, voffA);
            PG8_WAIT_V(8); PG8_WAIT_L(0); PG8_BAR; PG8_MMA(0, 0, At, B0); PG8_MMA(0, 1, At, B1); PG8_BAR; PG8_SCHED;
            PG8_LDA(At, 0, 1); PG8_STAGE(PG8_SB(0, 0), b2, voffB); PG8_STAGE(PG8_SB(0, 1), b2 + hstep, voffB); PG8_STAGE(PG8_SA(0, 0), a2, voffA);
            PG8_WAIT_V(8); PG8_WAIT_L(0); PG8_BAR; PG8_MMA(1, 0, At, B0); PG8_MMA(1, 1, At, B1); PG8_BAR; PG8_SCHED;
            PG8_LDB(B0, 1, 0); PG8_LDB(B1, 1, 1); PG8_SCHED; PG8_LDA(At, 1, 0); PG8_STAGE(PG8_SA(0, 1), a2 + hstep, voffA);
            PG8_WAIT_V(8); PG8_WAIT_L(0); PG8_BAR; PG8_MMA(0, 0, At, B0); PG8_MMA(0, 1, At, B1); PG8_BAR; PG8_SCHED;
            PG8_LDA(At, 1, 1); PG8_STAGE(PG8_SB(1, 0), b3, voffB); PG8_STAGE(PG8_SB(1, 1), b3 + hstep, voffB); PG8_STAGE(PG8_SA(1, 0), a3, voffA);
            PG8_WAIT_V(8); PG8_WAIT_L(0); PG8_BAR; PG8_MMA(1, 0, At, B0); PG8_MMA(1, 1, At, B1); PG8_BAR; PG8_SCHED;
            } else {
            PG8_LDB(B0, 0, 0); PG8_SCHED; PG8_LDA(At, 0, 0); PG8_STAGE(PG8_SA(1, 1), a1 + hstep, voffA);
            PG8_WAIT_L(8); PG8_BAR; PG8_WAIT_L(0); PG8_MMA(0, 0, At, B0); PG8_BAR; PG8_SCHED;
            PG8_LDB(B1, 0, 1); PG8_STAGE(PG8_SB(0, 0), b2, voffB);
            PG8_BAR; PG8_WAIT_L(0); PG8_MMA(0, 1, At, B1); PG8_BAR;
            PG8_LDA(At, 0, 1); PG8_STAGE(PG8_SA(0, 0), a2, voffA);
            PG8_BAR; PG8_WAIT_L(0); PG8_MMA(1, 0, At, B0); PG8_BAR; PG8_SCHED;
            PG8_STAGE(PG8_SB(0, 1), b2 + hstep, voffB);
            PG8_WAIT_V(6); PG8_BAR; PG8_MMA(1, 1, At, B1); PG8_BAR;
            PG8_LDB(B0, 1, 0); PG8_SCHED; PG8_LDA(At, 1, 0); PG8_STAGE(PG8_SA(0, 1), a2 + hstep, voffA);
            PG8_WAIT_L(8); PG8_BAR; PG8_WAIT_L(0); PG8_MMA(0, 0, At, B0); PG8_BAR; PG8_SCHED;
            PG8_LDB(B1, 1, 1); PG8_STAGE(PG8_SB(1, 0), b3, voffB);
            PG8_BAR; PG8_WAIT_L(0); PG8_MMA(0, 1, At, B1); PG8_BAR;
            PG8_LDA(At, 1, 1); PG8_STAGE(PG8_SA(1, 0), a3, voffA);
            PG8_BAR; PG8_WAIT_L(0); PG8_MMA(1, 0, At, B0); PG8_BAR; PG8_SCHED;
            PG8_STAGE(PG8_SB(1, 1), b3 + hstep, voffB);
            PG8_WAIT_V(6); PG8_BAR; PG8_MMA(1, 1, At, B1); PG8_BAR;
            }
        }
        if constexpr (ALIGN_EPI) { if (wr == 0) PG8_BAR; }
        if constexpr (!Epi::AFTER_DRAIN) { E(acc, cur, wr, wc, fr, fq); S.done(cur); }
        if (!has_next) break;
#pragma unroll
        for (int a = 0; a < 2; ++a)
#pragma unroll
            for (int b = 0; b < 2; ++b)
#pragma unroll
                for (int m = 0; m < 4; ++m)
#pragma unroll
                    for (int n = 0; n < 2; ++n) acc[a][b][m][n] = (f32x4){0.f, 0.f, 0.f, 0.f};
        cur = nxt; cA = nA; cB = nB; ++ui;
        if constexpr (ALIGN_EPI) { if (wr == 1) PG8_BAR; }
    }
    PG8_WAIT_V(0);
    if constexpr (!ALIGN_EPI) { if (wr == 0) PG8_BAR; }
    PG8_BAR;
    if constexpr (Epi::AFTER_DRAIN) { E.fused(acc, cur, wr, wc, fr, fq, lds, wid, lane); S.done(cur); }
#undef PG8_SA
#undef PG8_SB
#undef PG8_STAGE
#undef PG8_LDA
#undef PG8_LDB
#undef PG8_MMA
#undef PG8_WAIT_V
#undef PG8_WAIT_L
#undef PG8_BAR
#undef PG8_SCHED
}
}

#define LAS __attribute__((address_space(3)))
typedef unsigned short bf16;
typedef unsigned v4u __attribute__((ext_vector_type(4)));
typedef unsigned v2u __attribute__((ext_vector_type(2)));
typedef float f32x4 __attribute__((ext_vector_type(4)));
typedef short bf16x8 __attribute__((ext_vector_type(8)));
constexpr int NWAVES = 8, NTHR = 512;
constexpr int DM = 2048, NP = 8192, NS = 1024, MT = NP + NS;
constexpr int NC = 10240, PW = 1024, LW = 2048;
constexpr int C_UA = 0, C_GA = 1024, C_UB = 2048, C_GB = 4096, C_MA = 6144, C_MB = 8192;
constexpr int NCHUNK = 32;
constexpr float LN_EPS = 1e-5f;
constexpr float DN_ALPHA = 1.41421356237309515f;
constexpr int LDS_MISC = 139264;
constexpr int LDS_JUNK = 131072 + 256;
constexpr int LDS_BYTES = 131072 + 256 + 8192;
constexpr size_t SZ_WIN = (size_t)NC * DM * 2, SZ_WPA = (size_t)DM * PW * 2, SZ_WPB = (size_t)DM * LW * 2, SZ_WOUT = (size_t)DM * DM * 2;
constexpr size_t SZ_POOLW = (size_t)4 * 256 * 256 * 2, SZ_LRUW = (size_t)16 * 128 * 128 * 2;
constexpr size_t WS_WIN = 0;
constexpr size_t WS_WPA = WS_WIN + 2 * SZ_WIN;
constexpr size_t WS_WPB = WS_WPA + 2 * SZ_WPA;
constexpr size_t WS_WOUT = WS_WPB + 2 * SZ_WPB;
constexpr int KCAT = PW + LW;
constexpr size_t WS_WCAT = WS_WPA, SZ_WCAT = (size_t)DM * KCAT * 2;
static_assert(2 * SZ_WCAT == 2 * SZ_WPA + 2 * SZ_WPB, "WCAT overlay");
constexpr size_t WS_POOLW = WS_WOUT + 2 * SZ_WOUT;
constexpr size_t WS_WA = WS_POOLW + 2 * SZ_POOLW;
constexpr size_t WS_WX = WS_WA + 2 * SZ_LRUW;
constexpr size_t WS_C8 = WS_WX + 2 * SZ_LRUW;
constexpr size_t WS_XB = WS_C8 + 2 * 2048 * 4;
constexpr size_t WS_PROJ = WS_XB + (size_t)MT * DM * 2;
constexpr size_t WS_YA = WS_PROJ + (size_t)MT * NC * 2;
constexpr size_t WS_YB = WS_YA + (size_t)MT * PW * 2;
constexpr size_t WS_HL = WS_YB + (size_t)MT * LW * 2;
constexpr size_t WS_PP = WS_HL + (size_t)MT * LW * 4;
constexpr size_t WS_TOT = WS_PP + (size_t)MT * LW * 4;
constexpr size_t WS_TMP = WS_TOT + (size_t)2 * 4 * NCHUNK * LW * 4;
constexpr size_t WS_CTL = WS_TMP + (size_t)MT * DM * 4;
constexpr size_t WS_TOT2 = WS_CTL + 16384;
constexpr size_t WS_PREF2 = WS_TOT2 + (size_t)4 * NCHUNK * LW * 8;
constexpr size_t CTL_BYTES = 16384 + (size_t)4 * NCHUNK * LW * 12;
constexpr size_t WS_END = WS_CTL + CTL_BYTES;
constexpr size_t O_Y = 0;
constexpr size_t O_POOLP = (size_t)MT * DM;
constexpr size_t O_CONVP = O_POOLP + (size_t)2 * 4 * 15 * PW;
constexpr size_t O_HP = O_CONVP + (size_t)2 * 4 * 3 * LW;
constexpr size_t O_POOLS = O_HP + (size_t)2 * 4 * LW;
constexpr size_t O_CONVS = O_POOLS + (size_t)2 * 128 * 15 * PW;
constexpr size_t O_HS = O_CONVS + (size_t)2 * 128 * 3 * LW;
constexpr size_t O_END = O_HS + (size_t)2 * 128 * LW;

#ifndef DUP_P0
#define DUP_P0 0
#endif
#ifndef DUP_G1
#define DUP_G1 0
#endif
#ifndef DUP_MIX
#define DUP_MIX 0
#endif
#ifndef DUP_FIX
#define DUP_FIX 0
#endif
#ifndef DUP_MERGE
#define DUP_MERGE 0
#endif
#ifndef DUP_OUT0
#define DUP_OUT0 0
#endif
struct Params { const float* in[21]; float* out; unsigned char* ws; int ph_lo, ph_hi; };

#define LDS_WAIT() asm volatile("s_waitcnt lgkmcnt(0)" ::: "memory")
__device__ __forceinline__ unsigned f2bf(float f) { unsigned u = __builtin_bit_cast(unsigned, f); return (u + 0x7fffu + ((u >> 16) & 1u)) >> 16; }
__device__ __forceinline__ unsigned pk2(float lo, float hi) { return f2bf(lo) | (f2bf(hi) << 16); }
__device__ __forceinline__ float bflo(unsigned w) { return __uint_as_float(w << 16); }
__device__ __forceinline__ float bfhi(unsigned w) { return __uint_as_float(w & 0xffff0000u); }
__device__ __forceinline__ float wave_sum(float v) {
#pragma unroll
    for (int o = 1; o < 64; o <<= 1) v += __shfl_xor(v, o);
    return v;
}

__device__ __forceinline__ void p0_transpose_item(const float* W, int K, int N, bf16* WT, LAS float* scr, int item, int lane, int ldw = 0, int koff = 0) {
    if (ldw == 0) ldw = K;
    const int nblk = N / 32, kb = item / nblk, nb = item % nblk, k0 = 64 * kb, n0 = 32 * nb;
    float tv_[32];
#pragma unroll
    for (int i = 0; i < 32; ++i) tv_[i] = W[(size_t)(k0 + 2 * i + (lane >> 5)) * N + n0 + (lane & 31)];
#pragma unroll
    for (int i = 0; i < 32; ++i) scr[(2 * i + (lane >> 5)) * 33 + (lane & 31)] = tv_[i];
    LDS_WAIT(); asm volatile("" ::: "memory");
    const int c = lane & 7;
#pragma unroll
    for (int j = 0; j < 4; ++j) { const int n = (lane >> 3) + 8 * j; const LAS float* s = scr + (8 * c) * 33 + n;
        v4u o; o.x = pk2(s[0 * 33], s[1 * 33]); o.y = pk2(s[2 * 33], s[3 * 33]); o.z = pk2(s[4 * 33], s[5 * 33]); o.w = pk2(s[6 * 33], s[7 * 33]);
        *(v4u*)(WT + (size_t)(n0 + n) * ldw + koff + k0 + 8 * c) = o; }
    LDS_WAIT(); asm volatile("" ::: "memory");
}
constexpr int I_IN = (DM / 64) * (NC / 32), I_PA = (PW / 64) * (DM / 32), I_PB = (LW / 64) * (DM / 32), I_OUT = (DM / 64) * (DM / 32);
constexpr int I_PL = 8 * (256 / 64) * (256 / 32), I_LR = 32 * (128 / 64) * (128 / 32);
constexpr int IT_IN = 0, IT_PA = 2 * I_IN, IT_PB = IT_PA + 2 * I_PA, IT_OUT = IT_PB + 2 * I_PB, IT_SMALL = IT_OUT + 2 * I_OUT, IT_END = IT_SMALL + I_PL + 2 * I_LR;
__device__ __forceinline__ void convert_range(LAS unsigned char* lds, const Params& p, const int lo, const int hi, const int gw, const int NGW) {
    int tid_ = threadIdx.x; asm volatile("" : "+v"(tid_)); const int lane = tid_ & 63, wave = tid_ >> 6;
    LAS float* scr = (LAS float*)(lds + wave * 16384);
    unsigned char* ws = p.ws; asm volatile("" : "+s"(ws));
    for (int it = lo + gw; it < hi; it += NGW) {
        int r = it;
        if (r < 2 * I_IN) { const int l = r / I_IN; r -= l * I_IN; p0_transpose_item(p.in[5] + (size_t)l * DM * NC, DM, NC, (bf16*)(ws + WS_WIN + l * SZ_WIN), scr, r, lane); continue; } r -= 2 * I_IN;
        if (r < 2 * I_PA) { const int l = r / I_PA; r -= l * I_PA; p0_transpose_item(p.in[16] + (size_t)l * PW * DM, PW, DM, (bf16*)(ws + WS_WCAT + l * SZ_WCAT), scr, r, lane, KCAT, 0); continue; } r -= 2 * I_PA;
        if (r < 2 * I_PB) { const int l = r / I_PB; r -= l * I_PB; p0_transpose_item(p.in[17] + (size_t)l * LW * DM, LW, DM, (bf16*)(ws + WS_WCAT + l * SZ_WCAT), scr, r, lane, KCAT, PW); continue; } r -= 2 * I_PB;
        if (r < 2 * I_OUT) { const int l = r / I_OUT; r -= l * I_OUT; p0_transpose_item(p.in[18] + (size_t)l * DM * DM, DM, DM, (bf16*)(ws + WS_WOUT + l * SZ_WOUT), scr, r, lane); continue; } r -= 2 * I_OUT;
        if (r < I_PL) { const int mi = r / 32; r -= mi * 32; p0_transpose_item(p.in[7] + (size_t)mi * 65536, 256, 256, (bf16*)(ws + WS_POOLW) + (size_t)mi * 65536, scr, r, lane); continue; } r -= I_PL;
        if (r < I_LR) { const int mi = r / 8; r -= mi * 8; p0_transpose_item(p.in[11] + (size_t)mi * 16384, 128, 128, (bf16*)(ws + WS_WA) + (size_t)mi * 16384, scr, r, lane); continue; } r -= I_LR;
        { const int mi = r / 8; r -= mi * 8; p0_transpose_item(p.in[13] + (size_t)mi * 16384, 128, 128, (bf16*)(ws + WS_WX) + (size_t)mi * 16384, scr, r, lane); }
    }
}
__device__ __forceinline__ void p0_prologue(LAS unsigned char* lds, const Params& p) {
    int tid_ = threadIdx.x; asm volatile("" : "+v"(tid_)); const int tid = tid_, lane = tid & 63, wave = tid >> 6;
    const int gw = blockIdx.x * NWAVES + wave, NGW = gridDim.x * NWAVES;
    unsigned char* ws = p.ws; asm volatile("" : "+s"(ws));
    if (gridDim.x == 256) { convert_range(lds, p, IT_IN, IT_IN + I_IN, gw, NGW); convert_range(lds, p, IT_SMALL, IT_END, gw, NGW); }
    else convert_range(lds, p, 0, IT_END, gw, NGW);
    bf16* XB = (bf16*)(ws + WS_XB);
    for (int m = gw; m < MT; m += NGW) {
        const float* xr = (m < NP) ? p.in[0] + (size_t)m * DM : p.in[1] + (size_t)(m - NP) * DM;
        unsigned long long* o8 = (unsigned long long*)(XB + (size_t)m * DM) + lane;
#pragma unroll
        for (int j = 0; j < 8; ++j) { const f32x4 v = *((const f32x4*)xr + lane + 64 * j); o8[64 * j] = (unsigned long long)pk2(v.x, v.y) | ((unsigned long long)pk2(v.z, v.w) << 32); }
    }
    float* C8 = (float*)(ws + WS_C8);
    for (int i = blockIdx.x * NTHR + tid; i < 2 * LW; i += gridDim.x * NTHR) { const float x = -p.in[15][i]; C8[i] = 8.0f * (fmaxf(x, 0.f) + log1pf(expf(-fabsf(x)))); }
}

__device__ __forceinline__ float mix_sigmoid(float v) { return __builtin_amdgcn_rcpf(1.0f + __expf(-v)); }
__device__ __forceinline__ float one_minus_exp(float x) {
    const float q = 1.f + x * (0.5f + x * (1.f / 6 + x * (1.f / 24 + x * (1.f / 120 + x * (1.f / 720 + x * (1.f / 5040))))));
    return (x > -0.3f) ? -x * q : 1.0f - __expf(x);
}
#define BF8_TO_F32(vw, lo, hi) const f32x4 lo = {bflo(vw.x), bfhi(vw.x), bflo(vw.y), bfhi(vw.y)}, hi = {bflo(vw.z), bfhi(vw.z), bflo(vw.w), bfhi(vw.w)}
#define RLX_AGENT __ATOMIC_RELAXED, __HIP_MEMORY_SCOPE_AGENT
__device__ __forceinline__ int mix_tile_row0(int s) { return s < 128 ? (s & 3) * 2048 + (s >> 2) * 64 : NP + (s - 128) * 64; }
__device__ __forceinline__ void mix_phase(LAS unsigned char* lds, const Params& p, const int layer) {
    int tid_ = threadIdx.x; asm volatile("" : "+v"(tid_)); const int tid = tid_, wid = __builtin_amdgcn_readfirstlane(tid >> 6), lane = tid & 63, fr = lane & 15, fq = lane >> 4;
    unsigned char* ws = p.ws; asm volatile("" : "+s"(ws));
    const bf16* PROJ = (const bf16*)(ws + WS_PROJ);
    float* out = p.out;
    const int G = (int)gridDim.x;
    constexpr int NUA = 288 * 4, NUB = 144 * 16;
    {
        LAS float* XC3 = (LAS float*)lds;
        LAS bf16* At2 = (LAS bf16*)(lds + 3 * 33792);
        LAS float* CWL = (LAS float*)(lds + 3 * 33792 + 2 * 17408);
        const int cw = wid * 16;
        const int q16 = tid & 15, yrow = tid >> 3, yc16 = (tid & 7) * 16;
        bf16x8 ba[4], bx[4]; float bav = 0.f, bxv = 0.f, c8v = 0.f;
        v4u pre[2][4];
#define MIX_PREFETCH_B(uu) do { const int s__ = (uu) >> 4, nb__ = (uu) & 15, r0__ = mix_tile_row0(s__); \
        if (s__ < 128) { _Pragma("unroll") for (int i__ = 0; i__ < 2; ++i__) { const int r__ = r0__ + (tid >> 4) + 32 * i__, t__ = r__ & 2047; const bf16* src__ = PROJ + (size_t)r__ * NC + C_UB + nb__ * 128 + q16 * 8; \
            _Pragma("unroll") for (int k__ = 0; k__ < 4; ++k__) { const int jb__ = 3 - k__; pre[i__][k__] = *(const v4u*)(src__ - ((jb__ <= t__) ? (size_t)jb__ * NC : 0)); } } } } while (0)
        const int u0 = (int)blockIdx.x;
        if (u0 < NUB) {
            const int nb = u0 & 15, c0 = nb * 128, ch = c0 + cw + fr;
            { const bf16* WA = (const bf16*)(ws + WS_WA) + (size_t)(layer * 16 + nb) * 16384 + (size_t)(cw + fr) * 128 + fq * 8;
              const bf16* WX = (const bf16*)(ws + WS_WX) + (size_t)(layer * 16 + nb) * 16384 + (size_t)(cw + fr) * 128 + fq * 8;
#pragma unroll
              for (int ks = 0; ks < 4; ++ks) { ba[ks] = *(const bf16x8*)(WA + ks * 32); bx[ks] = *(const bf16x8*)(WX + ks * 32); }
              bav = p.in[12][layer * LW + ch]; bxv = p.in[14][layer * LW + ch]; c8v = ((const float*)(ws + WS_C8))[layer * LW + ch]; }
            MIX_PREFETCH_B(u0);
            __syncthreads();
            for (int i = tid; i < 5 * 128; i += NTHR) { const int k = i >> 7, cc = i & 127; CWL[i] = (k == 0) ? p.in[10][(size_t)layer * LW + c0 + cc] : p.in[9][((size_t)layer * 4 + (k - 1)) * LW + c0 + cc]; }
            __syncthreads();
            {
                const int r0N = mix_tile_row0(u0 >> 4); const bool prtN = (u0 >> 4) < 128; LAS float* XCN = XC3; LAS bf16* AtN = At2;
            if (prtN) {
                const f32x4 cb0 = *(const LAS f32x4*)(CWL + q16 * 8), cb1 = *(const LAS f32x4*)(CWL + q16 * 8 + 4);
#pragma unroll
                for (int i = 0; i < 2; ++i) {
                    const int rl = (tid >> 4) + 32 * i, t = (r0N + rl) & 2047;
                    f32x4 x0 = cb0, x1 = cb1;
#pragma unroll
                    for (int k = 0; k < 4; ++k) { const float f = ((3 - k) <= t) ? 1.0f : 0.0f;
                        const f32x4 w0 = *(const LAS f32x4*)(CWL + (k + 1) * 128 + q16 * 8), w1 = *(const LAS f32x4*)(CWL + (k + 1) * 128 + q16 * 8 + 4);
                        BF8_TO_F32(pre[i][k], a0, a1); x0 += w0 * (a0 * f); x1 += w1 * (a1 * f); }
                    *(LAS f32x4*)(XCN + rl * 132 + q16 * 8) = x0; *(LAS f32x4*)(XCN + rl * 132 + q16 * 8 + 4) = x1;
                    v4u o; o.x = pk2(x0[0], x0[1]); o.y = pk2(x0[2], x0[3]); o.z = pk2(x1[0], x1[1]); o.w = pk2(x1[2], x1[3]);
                    *(LAS v4u*)(AtN + rl * 136 + q16 * 8) = o;
                }
            } else {
                const float* sconv = p.in[3] + (size_t)layer * 128 * 3 * LW;
#pragma unroll 1
                for (int i = 0; i < 2; ++i) {
                    const int rl = (tid >> 4) + 32 * i, r = r0N + rl, c = c0 + q16 * 8, t = (r - NP) & 7, bs = (r - NP) >> 3;
                    f32x4 x0 = *(const LAS f32x4*)(CWL + q16 * 8), x1 = *(const LAS f32x4*)(CWL + q16 * 8 + 4);
#pragma unroll
                    for (int k = 0; k < 4; ++k) { const int jb = 3 - k;
                        const f32x4 w0 = *(const LAS f32x4*)(CWL + (k + 1) * 128 + q16 * 8), w1 = *(const LAS f32x4*)(CWL + (k + 1) * 128 + q16 * 8 + 4);
                        if (jb <= t) { const v4u vw = *(const v4u*)(PROJ + (size_t)(r - jb) * NC + C_UB + c); BF8_TO_F32(vw, a0, a1); x0 += w0 * a0; x1 += w1 * a1; }
                        else { const float* sp = sconv + ((size_t)bs * 3 + (3 + t - jb)) * LW + c; x0 += w0 * *(const f32x4*)sp; x1 += w1 * *(const f32x4*)(sp + 4); }
                    }
                    *(LAS f32x4*)(XCN + rl * 132 + q16 * 8) = x0; *(LAS f32x4*)(XCN + rl * 132 + q16 * 8 + 4) = x1;
                    v4u o; o.x = pk2(x0[0], x0[1]); o.y = pk2(x0[2], x0[3]); o.z = pk2(x1[0], x1[1]); o.w = pk2(x1[2], x1[3]);
                    *(LAS v4u*)(AtN + rl * 136 + q16 * 8) = o;
                }
            }
            }
            if (u0 + G < NUB) MIX_PREFETCH_B(u0 + G);
            __syncthreads();
            int xb = 0, ab = 0;
            for (int u = u0; u < NUB; u += G) {
                const int s_ = u >> 4, r0 = mix_tile_row0(s_);
                const bool prt = s_ < 128;
                LAS float* XC = XC3 + xb * (33792 / 4); LAS bf16* At = At2 + ab * (17408 / 2);
                const int xbn = (xb == 2) ? 0 : xb + 1, abn = ab ^ 1;
                const v4u sgc0 = *(const v4u*)(PROJ + (size_t)(r0 + yrow) * NC + C_GB + c0 + yc16), sgc1 = *(const v4u*)(PROJ + (size_t)(r0 + yrow) * NC + C_GB + c0 + yc16 + 8);
            f32x4 accr[4], acci[4];
#pragma unroll
            for (int m = 0; m < 4; ++m) { accr[m] = (f32x4){0.f, 0.f, 0.f, 0.f}; acci[m] = (f32x4){0.f, 0.f, 0.f, 0.f}; }
#pragma unroll
            for (int ks = 0; ks < 4; ++ks)
#pragma unroll
                for (int m = 0; m < 4; ++m) { const bf16x8 a = *(const LAS bf16x8*)(At + (m * 16 + fr) * 136 + ks * 32 + fq * 8);
                    accr[m] = __builtin_amdgcn_mfma_f32_16x16x32_bf16(a, ba[ks], accr[m], 0, 0, 0);
                    acci[m] = __builtin_amdgcn_mfma_f32_16x16x32_bf16(a, bx[ks], acci[m], 0, 0, 0); }
            float hl[4][4], pl[4][4];
            float Hc = 0.f, Pc = 1.f;
            const int gq = prt ? fq : (fq & 1);
            float h0s[4] = {0.f, 0.f, 0.f, 0.f};
            if (!prt) {
#pragma unroll
                for (int m = 0; m < 4; ++m) h0s[m] = p.in[4][(size_t)(layer * 128 + ((r0 - NP) >> 3) + 2 * m + (fq >> 1)) * LW + ch];
            }
#pragma unroll
            for (int m = 0; m < 4; ++m) {
                float h_[4], P_[4];
#pragma unroll
                for (int j = 0; j < 4; ++j) { const float xa = XC[(m * 16 + fq * 4 + j) * 132 + cw + fr];
                    const float rg = mix_sigmoid(accr[m][j] + bav), ig = mix_sigmoid(acci[m][j] + bxv), la = -rg * c8v, x2 = 2.0f * la;
                    const float Pj = __expf(la);
                    const float q_ = 1.f + x2 * (0.5f + x2 * (1.f / 6 + x2 * (1.f / 24 + x2 * (1.f / 120 + x2 * (1.f / 720 + x2 * (1.f / 5040))))));
                    const float om = (x2 > -0.3f) ? -x2 * q_ : 1.0f - Pj * Pj;
                    P_[j] = Pj; h_[j] = __builtin_amdgcn_sqrtf(om) * (ig * xa); }
#pragma unroll
                for (int j = 1; j < 4; ++j) { h_[j] = P_[j] * h_[j - 1] + h_[j]; P_[j] = P_[j] * P_[j - 1]; }
                float Pg = P_[3], Hg = h_[3];
                { const float Pu = __shfl_up(Pg, 16), Hu = __shfl_up(Hg, 16); if (gq >= 1) { Hg = Pg * Hu + Hg; Pg = Pg * Pu; } }
                { const float Pu = __shfl_up(Pg, 32), Hu = __shfl_up(Hg, 32); if (gq >= 2) { Hg = Pg * Hu + Hg; Pg = Pg * Pu; } }
                float Pe = __shfl_up(Pg, 16), He = __shfl_up(Hg, 16); if (gq == 0) { Pe = 1.f; He = 0.f; }
                const float Hcm = prt ? Hc : h0s[m];
                const float Hin = Pe * Hcm + He, Pin = Pe * Pc;
#pragma unroll
                for (int j = 0; j < 4; ++j) { hl[m][j] = h_[j] + P_[j] * Hin; pl[m][j] = P_[j] * Pin; }
                const float hb = __shfl(hl[m][3], 48 + fr), pb_ = __shfl(pl[m][3], 48 + fr);
                Hc = prt ? hb : 0.f; Pc = prt ? pb_ : 1.f;
            }
            if (!prt && (fq & 1)) {
#pragma unroll
                for (int m = 0; m < 4; ++m) out[O_HS + (size_t)(layer * 128 + ((r0 - NP) >> 3) + 2 * m + (fq >> 1)) * LW + ch] = hl[m][3];
            }
                if (prt) {
                const int b_ = r0 >> 11, c_ = (r0 & 2047) >> 6;
                const unsigned tag = (unsigned)layer + 1u;
                unsigned long long* T1 = (unsigned long long*)(ws + WS_TOT2) + (size_t)(b_ * 32) * LW + ch;
                unsigned* PF = (unsigned*)(ws + WS_PREF2) + (size_t)(b_ * 32) * LW + ch;
                if (fq == 0) __hip_atomic_store(T1 + (size_t)c_ * LW, ((unsigned long long)__float_as_uint(Hc) << 32) | (unsigned long long)((__float_as_uint(Pc) & ~3u) | tag), RLX_AGENT);
                }
                if (u + G < NUB) {
                    const int r0N = mix_tile_row0((u + G) >> 4); const bool prtN = ((u + G) >> 4) < 128; LAS float* XCN = XC3 + xbn * (33792 / 4); LAS bf16* AtN = At2 + abn * (17408 / 2);
            if (prtN) {
                const f32x4 cb0 = *(const LAS f32x4*)(CWL + q16 * 8), cb1 = *(const LAS f32x4*)(CWL + q16 * 8 + 4);
#pragma unroll
                for (int i = 0; i < 2; ++i) {
                    const int rl = (tid >> 4) + 32 * i, t = (r0N + rl) & 2047;
                    f32x4 x0 = cb0, x1 = cb1;
#pragma unroll
                    for (int k = 0; k < 4; ++k) { const float f = ((3 - k) <= t) ? 1.0f : 0.0f;
                        const f32x4 w0 = *(const LAS f32x4*)(CWL + (k + 1) * 128 + q16 * 8), w1 = *(const LAS f32x4*)(CWL + (k + 1) * 128 + q16 * 8 + 4);
                        BF8_TO_F32(pre[i][k], a0, a1); x0 += w0 * (a0 * f); x1 += w1 * (a1 * f); }
                    *(LAS f32x4*)(XCN + rl * 132 + q16 * 8) = x0; *(LAS f32x4*)(XCN + rl * 132 + q16 * 8 + 4) = x1;
                    v4u o; o.x = pk2(x0[0], x0[1]); o.y = pk2(x0[2], x0[3]); o.z = pk2(x1[0], x1[1]); o.w = pk2(x1[2], x1[3]);
                    *(LAS v4u*)(AtN + rl * 136 + q16 * 8) = o;
                }
            } else {
                const float* sconv = p.in[3] + (size_t)layer * 128 * 3 * LW;
#pragma unroll 1
                for (int i = 0; i < 2; ++i) {
                    const int rl = (tid >> 4) + 32 * i, r = r0N + rl, c = c0 + q16 * 8, t = (r - NP) & 7, bs = (r - NP) >> 3;
                    f32x4 x0 = *(const LAS f32x4*)(CWL + q16 * 8), x1 = *(const LAS f32x4*)(CWL + q16 * 8 + 4);
#pragma unroll
                    for (int k = 0; k < 4; ++k) { const int jb = 3 - k;
                        const f32x4 w0 = *(const LAS f32x4*)(CWL + (k + 1) * 128 + q16 * 8), w1 = *(const LAS f32x4*)(CWL + (k + 1) * 128 + q16 * 8 + 4);
                        if (jb <= t) { const v4u vw = *(const v4u*)(PROJ + (size_t)(r - jb) * NC + C_UB + c); BF8_TO_F32(vw, a0, a1); x0 += w0 * a0; x1 += w1 * a1; }
                        else { const float* sp = sconv + ((size_t)bs * 3 + (3 + t - jb)) * LW + c; x0 += w0 * *(const f32x4*)sp; x1 += w1 * *(const f32x4*)(sp + 4); }
                    }
                    *(LAS f32x4*)(XCN + rl * 132 + q16 * 8) = x0; *(LAS f32x4*)(XCN + rl * 132 + q16 * 8 + 4) = x1;
                    v4u o; o.x = pk2(x0[0], x0[1]); o.y = pk2(x0[2], x0[3]); o.z = pk2(x1[0], x1[1]); o.w = pk2(x1[2], x1[3]);
                    *(LAS v4u*)(AtN + rl * 136 + q16 * 8) = o;
                }
            }
                    if (u + 2 * G < NUB) MIX_PREFETCH_B(u + 2 * G);
                }
                if (prt) {
                const int b_ = r0 >> 11, c_ = (r0 & 2047) >> 6;
                const unsigned tag = (unsigned)layer + 1u;
                unsigned long long* T1 = (unsigned long long*)(ws + WS_TOT2) + (size_t)(b_ * 32) * LW + ch;
                unsigned* PF = (unsigned*)(ws + WS_PREF2) + (size_t)(b_ * 32) * LW + ch;
                float Hin = 0.f;
                if (c_ > 0) {
                    float Pacc = 1.f, Hacc = 0.f; bool done = false;
                    for (int base = 0; !done; base += 4) {
                        const int jc = c_ - 1 - base - fq;
                        unsigned long long w1 = 0ull; unsigned w2 = 0u, spins = 0u; int gstop = 4;
                        for (;;) {
                            bool v1 = true, v2 = true;
                            if (jc >= 0) { w1 = __hip_atomic_load(T1 + (size_t)jc * LW, RLX_AGENT); w2 = __hip_atomic_load(PF + (size_t)jc * LW, RLX_AGENT);
                                v1 = (((unsigned)w1) & 3u) == tag; v2 = (w2 & 3u) == tag; }
                            const unsigned long long m1 = __ballot(v1), m2 = __ballot(v2);
                            bool decided = true; gstop = 4;
#pragma unroll
                            for (int g = 3; g >= 0; --g) {
                                const unsigned s2 = (unsigned)(m2 >> (16 * g)) & 0xFFFFu, s1 = (unsigned)(m1 >> (16 * g)) & 0xFFFFu;
                                if (s2 == 0xFFFFu) { gstop = g; decided = true; } else if (s1 != 0xFFFFu) { gstop = 4; decided = false; }
                            }
                            if (decided || ++spins > (1u << 22)) break;
                        }
                        const float Pv = __uint_as_float(((unsigned)w1) & ~3u), Hv = __uint_as_float((unsigned)(w1 >> 32)), Fv = (jc >= 0) ? __uint_as_float(w2 & ~3u) : 0.f;
#pragma unroll
                        for (int g = 0; g < 4; ++g) {
                            const float Pg_ = __shfl(Pv, 16 * g + fr), Hg_ = __shfl(Hv, 16 * g + fr), Fg_ = __shfl(Fv, 16 * g + fr);
                            if (!done) { if (g == gstop) { Hin = Pacc * Fg_ + Hacc; done = true; } else if (g < gstop) { Hacc = Hacc + Pacc * Hg_; Pacc = Pacc * Pg_; } }
                        }
                        if (spins > (1u << 20)) done = true;
                    }
                }
                const float Hout = Pc * Hin + Hc;
                if (fq == 0) __hip_atomic_store(PF + (size_t)c_ * LW, (__float_as_uint(Hout) & ~3u) | tag, RLX_AGENT);
                if (c_ == 31 && fq == 0) out[O_HP + (size_t)(layer * 4 + b_) * LW + ch] = Hout;
#pragma unroll
                    for (int m = 0; m < 4; ++m)
#pragma unroll
                        for (int jj = 0; jj < 4; ++jj) hl[m][jj] = hl[m][jj] + pl[m][jj] * Hin;
                }
#pragma unroll
                for (int m = 0; m < 4; ++m)
#pragma unroll
                    for (int jj = 0; jj < 4; ++jj) XC[(m * 16 + fq * 4 + jj) * 132 + cw + fr] = hl[m][jj];
                __syncthreads();
            {
                const int row = yrow, c16 = yc16; const size_t r = (size_t)(r0 + row);
                const v4u g0 = sgc0, g1 = sgc1;
                const f32x4 h0 = *(const LAS f32x4*)(XC + row * 132 + c16), h1 = *(const LAS f32x4*)(XC + row * 132 + c16 + 4),
                            h2 = *(const LAS f32x4*)(XC + row * 132 + c16 + 8), h3 = *(const LAS f32x4*)(XC + row * 132 + c16 + 12);
                v4u o0, o1;
                o0.x = pk2(h0[0] * bflo(g0.x), h0[1] * bfhi(g0.x)); o0.y = pk2(h0[2] * bflo(g0.y), h0[3] * bfhi(g0.y)); o0.z = pk2(h1[0] * bflo(g0.z), h1[1] * bfhi(g0.z)); o0.w = pk2(h1[2] * bflo(g0.w), h1[3] * bfhi(g0.w));
                o1.x = pk2(h2[0] * bflo(g1.x), h2[1] * bfhi(g1.x)); o1.y = pk2(h2[2] * bflo(g1.y), h2[3] * bfhi(g1.y)); o1.z = pk2(h3[0] * bflo(g1.z), h3[1] * bfhi(g1.z)); o1.w = pk2(h3[2] * bflo(g1.w), h3[3] * bfhi(g1.w));
                bf16* yp = (bf16*)(ws + WS_YA) + r * KCAT + PW + c0 + c16;
                *(v4u*)yp = o0; *(v4u*)(yp + 8) = o1;
            }
                xb = xbn; ab = abn;
            }
        }
#undef MIX_PREFETCH_B
    }
    __syncthreads();
    {
        LAS float* SL = (LAS float*)lds;
        LAS bf16* At = (LAS bf16*)(lds + 92 * 264 * 4);
        const int q = tid & 31, i0 = tid >> 5;
        int g_cur = -1;
        bf16x8 b[2][8]; f32x4 ps[2];
        v4u vw[3]; v2u sgv[2][2];
#define MIX_PREFETCH_A(uu) do { const int g__ = (uu) & 3, r0__ = ((uu) >> 2) * 32; \
        _Pragma("unroll") for (int n__ = 0; n__ < 2; ++n__) _Pragma("unroll") for (int m__ = 0; m__ < 2; ++m__) \
            sgv[m__][n__] = *(const v2u*)(PROJ + (size_t)(r0__ + m__ * 16 + fr) * NC + C_GA + g__ * 256 + wid * 32 + n__ * 16 + fq * 4); \
        if (r0__ < NP) { const int t0__ = r0__ & 2047; _Pragma("unroll") for (int k__ = 0; k__ < 3; ++k__) { const int i__ = i0 + 16 * k__; const bool ok__ = (i__ < 47) && (t0__ - 15 + i__ >= 0); \
            vw[k__] = *(const v4u*)(PROJ + (size_t)(ok__ ? r0__ - 15 + i__ : r0__) * NC + C_UA + g__ * 256 + q * 8); } } } while (0)
        int ua = (int)blockIdx.x;
        if (ua < NUA) MIX_PREFETCH_A(ua);
        for (; ua < NUA; ua += G) {
            const int tt = ua >> 2, g = ua & 3, r0 = tt * 32, w = 2 << g;
            const bool prt = r0 < NP;
            const int col = g * 256 + q * 8;
            __syncthreads();
            if (g != g_cur) { g_cur = g;
                const bf16* WT = (const bf16*)(ws + WS_POOLW) + (size_t)(layer * 4 + g) * 65536 + (size_t)(wid * 32 + fr) * 256 + fq * 8;
#pragma unroll
                for (int n = 0; n < 2; ++n)
#pragma unroll
                    for (int ks = 0; ks < 8; ++ks) b[n][ks] = *(const bf16x8*)(WT + (size_t)n * 16 * 256 + ks * 32);
#pragma unroll
                for (int n = 0; n < 2; ++n) ps[n] = *(const f32x4*)(p.in[8] + layer * PW + g * 256 + wid * 32 + n * 16 + fq * 4); }
            if (prt) {
                const int t0 = r0 & 2047;
#pragma unroll
                for (int k = 0; k < 3; ++k) { const int i = i0 + 16 * k; const float f = ((i < 47) && (t0 - 15 + i >= 0)) ? 1.0f : 0.0f; BF8_TO_F32(vw[k], a0, a1);
                    if (i < 47) { *(LAS f32x4*)(SL + i * 264 + q * 8) = a0 * f; *(LAS f32x4*)(SL + i * 264 + q * 8 + 4) = a1 * f; } }
            } else {
                const float* spool = p.in[2] + (size_t)layer * 128 * 15 * PW; const int bs0 = (r0 - NP) >> 3;
#pragma unroll 2
                for (int i = tid >> 5; i < 92; i += 16) { const int sq = i / 23, ii = i - sq * 23; f32x4 a0, a1;
                    if (ii < 15) { const float* sp = spool + ((size_t)(bs0 + sq) * 15 + ii) * PW + col; a0 = *(const f32x4*)sp; a1 = *(const f32x4*)(sp + 4); }
                    else { const v4u vv = *(const v4u*)(PROJ + (size_t)(NP + (bs0 + sq) * 8 + (ii - 15)) * NC + C_UA + col); BF8_TO_F32(vv, c0_, c1_); a0 = c0_; a1 = c1_; }
                    *(LAS f32x4*)(SL + i * 264 + q * 8) = a0; *(LAS f32x4*)(SL + i * 264 + q * 8 + 4) = a1; }
            }
            __syncthreads();
            v2u sgc[2][2];
#pragma unroll
            for (int m = 0; m < 2; ++m)
#pragma unroll
                for (int n = 0; n < 2; ++n) sgc[m][n] = sgv[m][n];
            if (ua + G < NUA) MIX_PREFETCH_A(ua + G);
#pragma unroll
            for (int i = 0; i < 2; ++i) {
                const int rl = (tid >> 5) + 16 * i, bi = prt ? rl + 15 : (rl >> 3) * 23 + 15 + (rl & 7), t = (r0 + rl) & 2047;
                const LAS float* sp = SL + bi * 264 + q * 8;
                const f32x4 u0 = *(const LAS f32x4*)sp, u1 = *(const LAS f32x4*)(sp + 4);
                f32x4 s0 = u0, s1 = u1;
#pragma unroll 4
                for (int j = 1; j < w; ++j) { s0 += *(const LAS f32x4*)(sp - j * 264); s1 += *(const LAS f32x4*)(sp - j * 264 + 4); }
                const int cnt = (prt && t + 1 < w) ? t + 1 : w; const float inv = 1.0f / (float)cnt;
                const f32x4 d0 = s0 * inv - u0, d1 = s1 * inv - u1;
                v4u o; o.x = pk2(d0[0], d0[1]); o.y = pk2(d0[2], d0[3]); o.z = pk2(d1[0], d1[1]); o.w = pk2(d1[2], d1[3]);
                *(LAS v4u*)(At + rl * 264 + q * 8) = o;
            }
            __syncthreads();
            f32x4 acc[2][2];
#pragma unroll
            for (int m = 0; m < 2; ++m)
#pragma unroll
                for (int n = 0; n < 2; ++n) acc[m][n] = (f32x4){0.f, 0.f, 0.f, 0.f};
#pragma unroll
            for (int ks = 0; ks < 8; ++ks) {
                bf16x8 a[2];
#pragma unroll
                for (int m = 0; m < 2; ++m) a[m] = *(const LAS bf16x8*)(At + (m * 16 + fr) * 264 + ks * 32 + fq * 8);
#pragma unroll
                for (int m = 0; m < 2; ++m)
#pragma unroll
                    for (int n = 0; n < 2; ++n) acc[m][n] = __builtin_amdgcn_mfma_f32_16x16x32_bf16(b[n][ks], a[m], acc[m][n], 0, 0, 0);
            }
            bf16* YA = (bf16*)(ws + WS_YA);
#pragma unroll
            for (int m = 0; m < 2; ++m)
#pragma unroll
                for (int n = 0; n < 2; ++n) { const int r = r0 + m * 16 + fr, ch = g * 256 + wid * 32 + n * 16 + fq * 4; const v2u sg = sgc[m][n];
                    const f32x4 y = acc[m][n] * ps[n] * (f32x4){bflo(sg.x), bfhi(sg.x), bflo(sg.y), bfhi(sg.y)};
                    v2u o; o.x = pk2(y[0], y[1]); o.y = pk2(y[2], y[3]); *(v2u*)(YA + (size_t)r * KCAT + ch) = o; }
        }
#undef MIX_PREFETCH_A
    }
    const int gt = blockIdx.x * NTHR + tid, GT = gridDim.x * NTHR;
    constexpr int N_PP = 4 * 15 * (PW / 4), N_CP = 4 * 3 * (LW / 4), N_PS = 128 * 15 * (PW / 4), N_CS = 128 * 3 * (LW / 4), N_ST = N_PP + N_CP + N_PS + N_CS;
    for (int it0 = gt; it0 < N_ST; it0 += 3 * GT) {
        const bf16* src[3]; const float* fsrc[3]; float* dst[3]; bool isf[3], ok[3];
#pragma unroll
        for (int k = 0; k < 3; ++k) {
            const int it = it0 + k * GT; ok[k] = it < N_ST; int r = ok[k] ? it : 0; isf[k] = false; src[k] = PROJ; fsrc[k] = p.in[2];
            if (r < N_PP) { const int c4 = r % (PW / 4), i = (r / (PW / 4)) % 15, b_ = r / (15 * (PW / 4));
                src[k] = PROJ + (size_t)(b_ * 2048 + 2033 + i) * NC + C_UA + c4 * 4; dst[k] = out + O_POOLP + ((size_t)(layer * 4 + b_) * 15 + i) * PW + c4 * 4; }
            else if ((r -= N_PP) < N_CP) { const int c4 = r % (LW / 4), i = (r / (LW / 4)) % 3, b_ = r / (3 * (LW / 4));
                src[k] = PROJ + (size_t)(b_ * 2048 + 2045 + i) * NC + C_UB + c4 * 4; dst[k] = out + O_CONVP + ((size_t)(layer * 4 + b_) * 3 + i) * LW + c4 * 4; }
            else if ((r -= N_CP) < N_PS) { const int c4 = r % (PW / 4), i = (r / (PW / 4)) % 15, bs = r / (15 * (PW / 4));
                dst[k] = out + O_POOLS + ((size_t)(layer * 128 + bs) * 15 + i) * PW + c4 * 4;
                if (i < 7) { isf[k] = true; fsrc[k] = p.in[2] + ((size_t)(layer * 128 + bs) * 15 + 8 + i) * PW + c4 * 4; } else src[k] = PROJ + (size_t)(NP + bs * 8 + (i - 7)) * NC + C_UA + c4 * 4; }
            else { r -= N_PS; const int c4 = r % (LW / 4), i = (r / (LW / 4)) % 3, bs = r / (3 * (LW / 4));
                src[k] = PROJ + (size_t)(NP + bs * 8 + 5 + i) * NC + C_UB + c4 * 4; dst[k] = out + O_CONVS + ((size_t)(layer * 128 + bs) * 3 + i) * LW + c4 * 4; }
        }
        v2u wv[3]; f32x4 fv[3];
#pragma unroll
        for (int k = 0; k < 3; ++k) { wv[k] = *(const v2u*)src[k]; fv[k] = *(const f32x4*)fsrc[k]; }
#pragma unroll
        for (int k = 0; k < 3; ++k) { const f32x4 v = isf[k] ? fv[k] : (f32x4){bflo(wv[k].x), bfhi(wv[k].x), bflo(wv[k].y), bfhi(wv[k].y)}; if (ok[k]) *(f32x4*)dst[k] = v; }
    }
}

__device__ __forceinline__ void ln_phase(const Params& p, const int layer, const int row_lo, const int row_hi, const int wg_id, const int n_wg) {
    int tid_ = threadIdx.x; asm volatile("" : "+v"(tid_)); const int tid = tid_, lane = tid & 63, wave = tid >> 6;
    const int gw = wg_id * NWAVES + wave, NGW = n_wg * NWAVES;
    unsigned char* ws = p.ws; asm volatile("" : "+s"(ws)); float* Z = p.out; bf16* XB = (bf16*)(ws + WS_XB);
    const float* g = p.in[19] + layer * DM; const float* bb = p.in[20] + layer * DM;
    const bf16* OB = (const bf16*)(ws + WS_TMP);
    for (int m0 = row_lo + gw; m0 < row_hi; m0 += 2 * NGW) {
        const int m1r = m0 + NGW; const bool ok1 = m1r < row_hi; const int m1 = ok1 ? m1r : m0;
        const v2u* ob0 = (const v2u*)(OB + (size_t)m0 * DM) + lane; const v2u* ob1 = (const v2u*)(OB + (size_t)m1 * DM) + lane;
        f32x4 v0[8], v1[8]; v2u w0[8], w1[8]; float s0 = 0.f, s1 = 0.f;
        if (layer == 0) {
            const f32x4* xr0 = (const f32x4*)((m0 < NP) ? p.in[0] + (size_t)m0 * DM : p.in[1] + (size_t)(m0 - NP) * DM) + lane;
            const f32x4* xr1 = (const f32x4*)((m1 < NP) ? p.in[0] + (size_t)m1 * DM : p.in[1] + (size_t)(m1 - NP) * DM) + lane;
#pragma unroll
            for (int j = 0; j < 8; ++j) { v0[j] = xr0[64 * j]; v1[j] = xr1[64 * j]; w0[j] = ob0[64 * j]; w1[j] = ob1[64 * j]; }
        } else {
            const v2u* xb0 = (const v2u*)(XB + (size_t)m0 * DM) + lane; const v2u* xb1 = (const v2u*)(XB + (size_t)m1 * DM) + lane;
            v2u a0[8], a1[8];
#pragma unroll
            for (int j = 0; j < 8; ++j) { a0[j] = xb0[64 * j]; a1[j] = xb1[64 * j]; w0[j] = ob0[64 * j]; w1[j] = ob1[64 * j]; }
#pragma unroll
            for (int j = 0; j < 8; ++j) { v0[j] = (f32x4){bflo(a0[j].x), bfhi(a0[j].x), bflo(a0[j].y), bfhi(a0[j].y)}; v1[j] = (f32x4){bflo(a1[j].x), bfhi(a1[j].x), bflo(a1[j].y), bfhi(a1[j].y)}; }
        }
#pragma unroll
        for (int j = 0; j < 8; ++j) { v0[j] = v0[j] * DN_ALPHA + (f32x4){bflo(w0[j].x), bfhi(w0[j].x), bflo(w0[j].y), bfhi(w0[j].y)};
            v1[j] = v1[j] * DN_ALPHA + (f32x4){bflo(w1[j].x), bfhi(w1[j].x), bflo(w1[j].y), bfhi(w1[j].y)};
            s0 += (v0[j].x + v0[j].y) + (v0[j].z + v0[j].w); s1 += (v1[j].x + v1[j].y) + (v1[j].z + v1[j].w); }
        const float mean0 = wave_sum(s0) * (1.f / DM), mean1 = wave_sum(s1) * (1.f / DM); float q0 = 0.f, q1 = 0.f;
#pragma unroll
        for (int j = 0; j < 8; ++j) { v0[j] = v0[j] - mean0; v1[j] = v1[j] - mean1;
            q0 += (v0[j].x * v0[j].x + v0[j].y * v0[j].y) + (v0[j].z * v0[j].z + v0[j].w * v0[j].w); q1 += (v1[j].x * v1[j].x + v1[j].y * v1[j].y) + (v1[j].z * v1[j].z + v1[j].w * v1[j].w); }
        const float rstd0 = 1.f / sqrtf(wave_sum(q0) * (1.f / DM) + LN_EPS), rstd1 = 1.f / sqrtf(wave_sum(q1) * (1.f / DM) + LN_EPS);
        f32x4* zr0 = (f32x4*)(Z + (size_t)m0 * DM) + lane; f32x4* zr1 = (f32x4*)(Z + (size_t)m1 * DM) + lane;
        unsigned long long* o80 = (unsigned long long*)(XB + (size_t)m0 * DM) + lane; unsigned long long* o81 = (unsigned long long*)(XB + (size_t)m1 * DM) + lane;
#pragma unroll
        for (int j = 0; j < 8; ++j) { const f32x4 gv = *((const f32x4*)g + lane + 64 * j), bv = *((const f32x4*)bb + lane + 64 * j);
            const f32x4 y0 = v0[j] * rstd0 * gv + bv, y1 = v1[j] * rstd1 * gv + bv;
            if (layer == 0) { o80[64 * j] = (unsigned long long)pk2(y0.x, y0.y) | ((unsigned long long)pk2(y0.z, y0.w) << 32);
                if (ok1) o81[64 * j] = (unsigned long long)pk2(y1.x, y1.y) | ((unsigned long long)pk2(y1.z, y1.w) << 32); }
            else { zr0[64 * j] = y0; if (ok1) zr1[64 * j] = y1; } }
    }
}

#define XB_TMO      128
#define XB_XCNT(j)  (256  + 64 * (j))
#define XB_XSUB(j)  (1280 + 64 * (j))
#define XB_XGEN(j)  (2304 + 64 * (j))
#define XB_TOP      3328
#define XB_TOPGEN   3392
#define XCD_BAR_WORDS 3456
#define XB_SPIN_CAP (1u << 18)

__device__ __forceinline__ unsigned xb_ld(unsigned* p)              { return __hip_atomic_load(p, __ATOMIC_RELAXED, __HIP_MEMORY_SCOPE_AGENT); }
__device__ __forceinline__ unsigned xb_add(unsigned* p, unsigned v) { return __hip_atomic_fetch_add(p, v, __ATOMIC_RELAXED, __HIP_MEMORY_SCOPE_AGENT); }
__device__ __forceinline__ unsigned xb_xcc_id() { return (unsigned)__builtin_amdgcn_s_getreg((3 << 11) | 20) & 0xFu; }
#define XB_SPIN(cond, bar) do { unsigned _sp = 0; while (cond) { __builtin_amdgcn_s_sleep(1); \
    if ((++_sp & 255u) == 0u) { if (xb_ld(&(bar)[XB_TMO])) break; if (_sp > XB_SPIN_CAP) { atomicAdd(&(bar)[XB_TMO], 1u); break; } } } } while (0)

struct XcdBarrier {
    unsigned* bar; unsigned x;
    volatile LAS unsigned* st;
};

__device__ __forceinline__ XcdBarrier xcd_barrier_post(unsigned* bar, volatile LAS unsigned* st) {
    XcdBarrier b; b.bar = bar; b.x = xb_xcc_id(); b.st = st;
    if (threadIdx.x == 0) (void)xb_add(&bar[XB_XCNT(b.x)], 1u);
    return b;
}
__device__ __forceinline__ void xcd_barrier_complete(unsigned* bar, unsigned x, unsigned& nloc, unsigned& nx) {
    const unsigned G = gridDim.x * gridDim.y * gridDim.z;
    unsigned sum, cnt, mine, sp = 0u;
    for (;;) {
        sum = 0u; cnt = 0u; mine = 0u;
#pragma unroll
        for (unsigned j = 0; j < 16; ++j) { const unsigned c = xb_ld(&bar[XB_XCNT(j)]); sum += c; cnt += (c > 0u) ? 1u : 0u; mine = (j == x) ? c : mine; }
        if (sum == G) break;
        __builtin_amdgcn_s_sleep(1);
        if ((++sp & 255u) == 0u) { if (xb_ld(&bar[XB_TMO])) break; if (sp > XB_SPIN_CAP) { atomicAdd(&bar[XB_TMO], 1u); break; } }
    }
    nloc = mine > 0u ? mine : 1u; nx = cnt > 0u ? cnt : 1u;
}

__device__ __forceinline__ void xcd_barrier(const XcdBarrier& b) {
    asm volatile("s_waitcnt vmcnt(0)" ::: "memory");
    __syncthreads();
    if (threadIdx.x == 0) {
        unsigned* bar = b.bar;
        __builtin_amdgcn_s_waitcnt(0);
        unsigned nloc = b.st[0], nx = b.st[1];
        if (nloc == 0u) { xcd_barrier_complete(bar, b.x, nloc, nx); b.st[0] = nloc; b.st[1] = nx; }
        const unsigned old = xb_add(&bar[XB_XSUB(b.x)], 1u);
        const unsigned gen = old / nloc;
        if (old + 1u == (gen + 1u) * nloc) {
            __builtin_amdgcn_fence(__ATOMIC_RELEASE, "agent");
            asm volatile("s_waitcnt vmcnt(0)" ::: "memory");
            const unsigned og = xb_add(&bar[XB_TOP], 1u);
            const unsigned tg = og / nx;
            if (og + 1u == (tg + 1u) * nx) xb_add(&bar[XB_TOPGEN], 1u);
            else XB_SPIN(xb_ld(&bar[XB_TOPGEN]) == tg, bar);
            __builtin_amdgcn_fence(__ATOMIC_ACQUIRE, "agent");
            xb_add(&bar[XB_XGEN(b.x)], 1u);
            asm volatile("s_waitcnt vmcnt(0)" ::: "memory");
        } else {
            XB_SPIN(xb_ld(&bar[XB_XGEN(b.x)]) == gen, bar);
            __builtin_amdgcn_fence(__ATOMIC_ACQUIRE, "agent");
            asm volatile("s_waitcnt vmcnt(0)" ::: "memory");
        }
    }
    __syncthreads();
}

constexpr int W1_EARLY = 1536;
constexpr int LN_EARLY_SPLIT = 24 * 256;
constexpr int LN_EARLY_ROWS = 28 * 256;
struct ListOrder {
    int start, stride, count;
    __device__ __forceinline__ bool next(int i, pg8::Unit& u) const { if (i >= count) return false; const int L = start + i * stride; u.pm = L >> 3; u.pn = L & 7; return true; }
    __device__ __forceinline__ void a_ready(const pg8::Unit&) const {}
    __device__ __forceinline__ void done(const pg8::Unit&) const {}
};
__device__ __forceinline__ int wave_id_l() { int t = threadIdx.x; asm volatile("" : "+v"(t)); return t >> 6; }
__global__ void __launch_bounds__(NTHR, 2) hybrid_fwd(Params p) {
    extern __shared__ __attribute__((aligned(16))) unsigned char lds_raw[];
    LAS unsigned char* lds = (LAS unsigned char*)lds_raw;
    cg::grid_group grid = cg::this_grid();
    volatile LAS unsigned* MISC = (volatile LAS unsigned*)(lds + LDS_MISC);
    if (threadIdx.x < 64) MISC[threadIdx.x] = 0u;
    __syncthreads();
    XcdBarrier bar = xcd_barrier_post((unsigned*)(p.ws + WS_CTL), MISC);
    if (p.ph_lo < 0) grid.sync();
    const int lo = p.ph_lo, hi = p.ph_hi;
#define IN(k) (lo <= (k) && (k) < hi)
#define SEAM(k) do { if (IN(k) && IN((k) + 1)) xcd_barrier(bar); } while (0)
#ifdef EXTRA_SYNCS
    for (int rep = 0; rep < EXTRA_SYNCS; ++rep) xcd_barrier(bar);
#endif
    if (IN(0)) { for (int rep = 0; rep <= DUP_P0; ++rep) p0_prologue(lds, p); }
    SEAM(0);
#pragma unroll 1
    for (int l = 0; l < 2; ++l) {
        const int pb = 1 + 6 * l;
        unsigned char* ws = p.ws; asm volatile("" : "+s"(ws));
        bf16* PROJ = (bf16*)(ws + WS_PROJ);
        if (IN(pb + 0)) {
            pg8::Gemm g{(const bf16*)(ws + WS_XB), (const bf16*)(ws + WS_WIN + l * SZ_WIN), MT, NC, DM, DM};
            pg8::StaticOrder S; S.init(MT, NC, (int)gridDim.x, (int)blockIdx.x);
            pg8::EpiProj E{PROJ, NC, p.in[6] + (size_t)l * 2 * DM};
            for (int rep = 0; rep <= DUP_G1; ++rep) pg8::gemm_phase<pg8::EpiProj, pg8::StaticOrder, true, true>(lds, g, S, E);
            if (gridDim.x == 256 && blockIdx.x >= 160) {
                const int gw = ((int)blockIdx.x - 160) * NWAVES + wave_id_l(), NGW = ((int)gridDim.x - 160) * NWAVES;
                convert_range(lds, p, IT_PA + l * I_PA, IT_PA + (l + 1) * I_PA, gw, NGW); convert_range(lds, p, IT_PB + l * I_PB, IT_PB + (l + 1) * I_PB, gw, NGW);
                convert_range(lds, p, IT_OUT + l * I_OUT, IT_OUT + (l + 1) * I_OUT, gw, NGW);
                if (l == 0) convert_range(lds, p, IT_IN + I_IN, IT_IN + I_IN + W1_EARLY, gw, NGW); }
            else if (l == 1 && gridDim.x != 256 && false) {}
        }
        SEAM(pb + 0);
        if (IN(pb + 1)) { for (int rep = 0; rep <= DUP_MIX; ++rep) mix_phase(lds, p, l); }
        SEAM(pb + 1);
        if (IN(pb + 3)) {
            const int c = (int)blockIdx.x, G = (int)gridDim.x; const bool g256 = (G == 256);
            constexpr int NU = (MT / 256) * (DM / 256);
#pragma unroll 1
            for (int step = 0; step < 3; ++step) {
                ListOrder SM{0, 1, 0}, SO{0, 1, 0};
                const bool split = g256;
                int kh = -1;
                if (split) {
                    if (step == 0) SM = ListOrder{c, 256, 1};
                    else if (step == 1) { if (c < 64) { SM = ListOrder{256 + (c >> 1), 256, 1}; kh = c & 1; } else SO = ListOrder{c - 64, 256, 1}; }
                    else { if (c >= 32 && c < 128) SO = ListOrder{192 + (c - 32), 256, 1}; }
                } else if (g256) {
                    if (step == 0) SM = ListOrder{c, 256, 1};
                    else if (step == 1) { if (c < 32) SM = ListOrder{256 + c, 256, 1}; else SO = ListOrder{c - 32, 256, 1}; }
                    else { if (c >= 32 && c < 96) SO = ListOrder{224 + (c - 32), 256, 1}; }
                } else {
                    if (step == 0) SM = ListOrder{c, G, c < NU ? (NU - 1 - c) / G + 1 : 0};
                    else if (step == 2) SO = ListOrder{c, G, c < NU ? (NU - 1 - c) / G + 1 : 0};
                }
                if (SM.count) {
                    const int ko = (kh == 1) ? KCAT / 2 : 0;
                    pg8::Gemm g{(const bf16*)(ws + WS_YA) + ko, (const bf16*)(ws + WS_WCAT + l * SZ_WCAT) + ko, MT, DM, (kh >= 0) ? KCAT / 2 : KCAT, KCAT};
                    pg8::EpiMerge E{(kh >= 0) ? (bf16*)(ws + WS_HL) + (size_t)kh * MT * DM : (bf16*)(ws + WS_PP), PROJ, NC, (kh == 1) ? -1 : PW / 64, (kh >= 0) ? 1 : 0};
                    pg8::gemm_phase<pg8::EpiMerge, ListOrder, true, true>(lds, g, SM, E);
                }
                if (SO.count) {
                    pg8::Gemm g{(const bf16*)(ws + WS_PP), (const bf16*)(ws + WS_WOUT + l * SZ_WOUT), MT, DM, DM, DM};
                    pg8::EpiOutB E{(bf16*)(ws + WS_TMP)};
                    pg8::gemm_phase<pg8::EpiOutB, ListOrder, true, true>(lds, g, SO, E);
                }
                if (l == 0 && split && step == 2 && (c < 32 || c >= 128)) {
                    const int gw = (c < 32 ? c : c - 96) * NWAVES + wave_id_l(), NGW = (G - 96) * NWAVES;
                    convert_range(lds, p, IT_IN + I_IN + W1_EARLY, IT_IN + 2 * I_IN, gw, NGW); }
                if (g256 && !split && step == 2 && (c < 32 || c >= 96)) ln_phase(p, l, 0, LN_EARLY_ROWS, c < 32 ? c : c - 64, G - 64);
                if (split && step == 2 && (c < 32 || c >= 128)) ln_phase(p, l, 0, LN_EARLY_SPLIT, c < 32 ? c : c - 96, G - 96);
                if (step < 2) xcd_barrier(bar);
                if (split && step == 1) {
                    const bf16* P0 = (const bf16*)(ws + WS_HL); const bf16* P1 = P0 + (size_t)MT * DM; bf16* MG = (bf16*)(ws + WS_PP);
                    for (int it = c * NTHR + (int)threadIdx.x; it < 1024 * 256; it += G * NTHR) { const size_t r = (size_t)(NP + (it >> 8)); const int c8 = (it & 255) * 8;
                        const v4u a = *(const v4u*)(P0 + r * DM + c8), b = *(const v4u*)(P1 + r * DM + c8), gq = *(const v4u*)(PROJ + r * NC + C_MB + c8);
                        v4u o;
                        o.x = pk2(fmaxf(bflo(gq.x), 1e-30f) * (bflo(a.x) + bflo(b.x)), fmaxf(bfhi(gq.x), 1e-30f) * (bfhi(a.x) + bfhi(b.x)));
                        o.y = pk2(fmaxf(bflo(gq.y), 1e-30f) * (bflo(a.y) + bflo(b.y)), fmaxf(bfhi(gq.y), 1e-30f) * (bfhi(a.y) + bfhi(b.y)));
                        o.z = pk2(fmaxf(bflo(gq.z), 1e-30f) * (bflo(a.z) + bflo(b.z)), fmaxf(bfhi(gq.z), 1e-30f) * (bfhi(a.z) + bfhi(b.z)));
                        o.w = pk2(fmaxf(bflo(gq.w), 1e-30f) * (bflo(a.w) + bflo(b.w)), fmaxf(bfhi(gq.w), 1e-30f) * (bfhi(a.w) + bfhi(b.w)));
                        *(v4u*)(MG + r * DM + c8) = o; }
                    xcd_barrier(bar);
                }
            }
        }
        SEAM(pb + 3);
        if (IN(pb + 5)) ln_phase(p, l, (gridDim.x == 256) ? LN_EARLY_SPLIT : 0, MT, (int)blockIdx.x, (int)gridDim.x);
        if (l == 0) SEAM(pb + 5);
    }
#undef IN
#undef SEAM
}

#ifndef MK_N_LAUNCHES
#define MK_N_LAUNCHES 1
#endif
extern "C" void kernel_launch(void* const* d_in, const int* in_sizes, int n_in, void* d_out, int out_size, void* d_ws, size_t ws_size, hipStream_t stream) {
    static int grid = 0;
    if (grid == 0) {
        if (n_in != 21 || (size_t)out_size != O_END || ws_size < WS_END) { fprintf(stderr, "kernel_launch: unexpected shapes: n_in %d out %d ws %zu (need %zu)\n", n_in, out_size, ws_size, (size_t)WS_END); grid = -1; return; }
        int dev = 0, cus = 0, per_cu = 0;
        if (hipGetDevice(&dev) != hipSuccess || hipDeviceGetAttribute(&cus, hipDeviceAttributeMultiprocessorCount, dev) != hipSuccess) { grid = -1; return; }
        if (hipFuncSetAttribute((const void*)hybrid_fwd, hipFuncAttributeMaxDynamicSharedMemorySize, LDS_BYTES) != hipSuccess) { fprintf(stderr, "kernel_launch: hipFuncSetAttribute failed\n"); grid = -1; return; }
        if (hipOccupancyMaxActiveBlocksPerMultiprocessor(&per_cu, (const void*)hybrid_fwd, NTHR, LDS_BYTES) != hipSuccess || per_cu < 1) { fprintf(stderr, "kernel_launch: occupancy query says %d\n", per_cu); per_cu = 1; }
        (void)hipGetLastError();
        grid = cus - cus % 16;
    }
    if (grid < 0) return;
    Params p{};
    for (int i = 0; i < 21; ++i) p.in[i] = (const float*)d_in[i];
    p.out = (float*)d_out; p.ws = (unsigned char*)d_ws;
    constexpr int NPH = 13;
    if (hipMemsetAsync((char*)d_ws + WS_CTL, 0, CTL_BYTES, stream) != hipSuccess) { fprintf(stderr, "kernel_launch: memset failed\n"); return; }
    if (MK_N_LAUNCHES == 1) {
        p.ph_lo = 0; p.ph_hi = NPH;
        void* args[] = {&p};
        const hipError_t e = hipLaunchCooperativeKernel((const void*)hybrid_fwd, dim3(grid), dim3(NTHR), args, LDS_BYTES, stream);
        if (e != hipSuccess) fprintf(stderr, "kernel_launch: cooperative launch failed: %s (grid %d)\n", hipGetErrorString(e), grid);
    } else {
        for (int ph = 0; ph < NPH; ++ph) { p.ph_lo = ph; p.ph_hi = ph + 1; hipLaunchKernelGGL(hybrid_fwd, dim3(grid), dim3(NTHR), LDS_BYTES, stream, p); }
    }
}
```

```cpp
#include <hip/hip_runtime.h>
#include <hip/hip_cooperative_groups.h>
#include <cstdio>
#include <cstdint>
namespace cg = cooperative_groups;

namespace pg8 {
#define PG8_LAS __attribute__((address_space(3)))
typedef unsigned short bf16_t;
typedef short bf16x8 __attribute__((ext_vector_type(8)));
typedef float f32x4 __attribute__((ext_vector_type(4)));
typedef unsigned u32x4 __attribute__((ext_vector_type(4)));
constexpr int BM = 256, BK = 64, HALF = 128, HTB = HALF * BK * 2  , STAGE_BYTES = 8 * HTB, NXCD = 8, WGM = 8;

__host__ __device__ __forceinline__ int lds_byte(int r, int c) { const int st = (r >> 4) * 2 + (c >> 5), rr = r & 15, cc = c & 31, ob = rr * 64 + cc * 2; return st * 1024 + (ob ^ (((ob >> 9) & 1) << 5)); }
__host__ __device__ __forceinline__ void stage_rc(int b, int& R, int& C) { const int st = b / 1024, sb = b % 1024, swz = sb ^ (((sb >> 9) & 1) << 5); R = (st >> 1) * 16 + swz / 64; C = (st & 1) * 32 + (swz % 64) / 2; }
__host__ __device__ __forceinline__ int perm32(int rho) { const int n = rho >> 4, i = rho & 15; return 8 * (i >> 2) + 4 * n + (i & 3); }

struct Unit { int pm, pn; };
struct Gemm { const bf16_t* A; const bf16_t* Bt; int M, N, K, ld; };

struct StaticOrder {
    int nM, nN, nwg, G, c;
    __host__ __device__ void init(int M, int N, int G_, int c_) { nM = M / BM; nN = N / BM; nwg = nM * nN; G = G_; c = c_; }
    __host__ __device__ bool next(int i, Unit& u) const {
        const long L = (long)i * G + c; if (L >= nwg) return false;
        int wgid = (int)L; { const int q = nwg / NXCD, r = nwg % NXCD, xcd = wgid % NXCD, off = wgid / NXCD; wgid = (xcd < r ? xcd * (q + 1) : r * (q + 1) + (xcd - r) * q) + off; }
        const int nig = WGM * nN, gid = wgid / nig, fm = gid * WGM, gsz = (nM - fm) < WGM ? (nM - fm) : WGM;
        u.pm = fm + ((wgid % nig) % gsz); u.pn = (wgid % nig) / gsz; return true;
    }
    __device__ __forceinline__ void a_ready(const Unit&) const {}
    __device__ __forceinline__ void done(const Unit&) const {}
};
__device__ __forceinline__ unsigned cvt_pk_bf16(float lo, float hi) { unsigned r; asm volatile("v_cvt_pk_bf16_f32 %0, %1, %2" : "=v"(r) : "v"(lo), "v"(hi)); return r; }
typedef unsigned u32x2 __attribute__((ext_vector_type(2)));
__device__ __forceinline__ float fast_sigmoid(float v) { return __builtin_amdgcn_rcpf(1.0f + __expf(-v)); }
struct EpiProj {
    static constexpr bool PERM = true, AFTER_DRAIN = false, HOOK = false;
    bf16_t* O; int ldc; const float* bmerge;
    __device__ __forceinline__ void operator()(const f32x4 (&acc)[2][2][4][2], const Unit& u, int wr, int wc, int fr, int fq) const {
        const int row0 = u.pm * BM + wr * 64 + fr; const int col0 = u.pn * BM + wc * 32 + 8 * fq;
        const int mode = (u.pn >= 24) ? 2 : (((u.pn >= 4 && u.pn < 8) || (u.pn >= 16)) ? 1 : 0);
        f32x4 bv[2][2];
#pragma unroll
        for (int bj = 0; bj < 2; ++bj)
#pragma unroll
            for (int n = 0; n < 2; ++n) bv[bj][n] = (mode == 2) ? *(const f32x4*)(bmerge + (col0 - 6144) + bj * HALF + 4 * n) : (f32x4){0.f, 0.f, 0.f, 0.f};
#pragma unroll
        for (int ai = 0; ai < 2; ++ai)
#pragma unroll
            for (int m = 0; m < 4; ++m) { bf16_t* rowp = O + (size_t)(row0 + ai * HALF + m * 16) * ldc + col0;
#pragma unroll
                for (int bj = 0; bj < 2; ++bj) { f32x4 v0 = acc[ai][bj][m][0] + bv[bj][0], v1 = acc[ai][bj][m][1] + bv[bj][1];
                    if (mode == 1) {
#pragma unroll
                        for (int j = 0; j < 4; ++j) { v0[j] = v0[j] * fast_sigmoid(v0[j]); v1[j] = v1[j] * fast_sigmoid(v1[j]); } }
                    else if (mode == 2) {
#pragma unroll
                        for (int j = 0; j < 4; ++j) { v0[j] = fast_sigmoid(v0[j]); v1[j] = fast_sigmoid(v1[j]); } }
                    u32x4 w; w.x = cvt_pk_bf16(v0[0], v0[1]); w.y = cvt_pk_bf16(v0[2], v0[3]); w.z = cvt_pk_bf16(v1[0], v1[1]); w.w = cvt_pk_bf16(v1[2], v1[3]);
                    *(u32x4*)(rowp + bj * HALF) = w; } }
    }
};
__device__ __forceinline__ void unpack_bf16x8(const u32x4 w, f32x4& lo, f32x4& hi) {
    lo[0] = __uint_as_float(w.x << 16); lo[1] = __uint_as_float(w.x & 0xffff0000u); lo[2] = __uint_as_float(w.y << 16); lo[3] = __uint_as_float(w.y & 0xffff0000u);
    hi[0] = __uint_as_float(w.z << 16); hi[1] = __uint_as_float(w.z & 0xffff0000u); hi[2] = __uint_as_float(w.w << 16); hi[3] = __uint_as_float(w.w & 0xffff0000u);
}
struct EpiMergeA {
    static constexpr bool PERM = true, AFTER_DRAIN = false, HOOK = false;
    float* T; const bf16_t* G; int ldg; int gcol0;
    __device__ __forceinline__ void operator()(const f32x4 (&acc)[2][2][4][2], const Unit& u, int wr, int wc, int fr, int fq) const {
        const int row0 = u.pm * BM + wr * 64 + fr; const int col0 = u.pn * BM + wc * 32 + 8 * fq;
#pragma unroll
        for (int ai = 0; ai < 2; ++ai)
#pragma unroll
            for (int m = 0; m < 4; ++m) { const size_t row = (size_t)(row0 + ai * HALF + m * 16);
#pragma unroll
                for (int bj = 0; bj < 2; ++bj) { const u32x4 gw = *(const u32x4*)(G + row * ldg + gcol0 + col0 + bj * HALF); f32x4 g0, g1; unpack_bf16x8(gw, g0, g1);
                    float* tp = T + row * 2048 + col0 + bj * HALF;
                    *(f32x4*)tp = acc[ai][bj][m][0] * g0; *(f32x4*)(tp + 4) = acc[ai][bj][m][1] * g1; }
                asm volatile("" ::: "memory"); }
    }
};
struct EpiMergeB {
    static constexpr bool PERM = true, AFTER_DRAIN = false, HOOK = false;
    const float* T; bf16_t* O; const bf16_t* G; int ldg; int gcol0;
    __device__ __forceinline__ void operator()(const f32x4 (&acc)[2][2][4][2], const Unit& u, int wr, int wc, int fr, int fq) const {
        const int row0 = u.pm * BM + wr * 64 + fr; const int col0 = u.pn * BM + wc * 32 + 8 * fq;
#pragma unroll
        for (int ai = 0; ai < 2; ++ai)
#pragma unroll
            for (int m = 0; m < 4; ++m) { const size_t row = (size_t)(row0 + ai * HALF + m * 16);
#pragma unroll
                for (int bj = 0; bj < 2; ++bj) { const u32x4 gw = *(const u32x4*)(G + row * ldg + gcol0 + col0 + bj * HALF); f32x4 g0, g1; unpack_bf16x8(gw, g0, g1);
                    const float* tp = T + row * 2048 + col0 + bj * HALF;
                    const f32x4 v0 = *(const f32x4*)tp + acc[ai][bj][m][0] * g0, v1 = *(const f32x4*)(tp + 4) + acc[ai][bj][m][1] * g1;
                    u32x4 w; w.x = cvt_pk_bf16(v0[0], v0[1]); w.y = cvt_pk_bf16(v0[2], v0[3]); w.z = cvt_pk_bf16(v1[0], v1[1]); w.w = cvt_pk_bf16(v1[2], v1[3]);
                    *(u32x4*)(O + row * 2048 + col0 + bj * HALF) = w; }
                asm volatile("" ::: "memory"); }
    }
};
struct EpiOut {
    static constexpr bool PERM = false, AFTER_DRAIN = false, HOOK = false;
    const float* xp; const float* xs; float* Z; float alpha;
    __device__ __forceinline__ void operator()(const f32x4 (&acc)[2][2][4][2], const Unit& u, int wr, int wc, int fr, int fq) const {
        const int row0 = u.pm * BM + wr * 64 + fr, col0 = u.pn * BM + wc * 32 + 4 * fq;
        const float* xb = (u.pm < 32) ? xp : (xs - (size_t)8192 * 2048);
#pragma unroll
        for (int ai = 0; ai < 2; ++ai)
#pragma unroll
            for (int m = 0; m < 4; ++m) { const size_t off = (size_t)(row0 + ai * HALF + m * 16) * 2048 + col0;
#pragma unroll
                for (int bj = 0; bj < 2; ++bj)
#pragma unroll
                    for (int n = 0; n < 2; ++n) { const f32x4 xv = *(const f32x4*)(xb + off + bj * HALF + n * 16);
                        *(f32x4*)(Z + off + bj * HALF + n * 16) = xv * alpha + acc[ai][bj][m][n]; }
                asm volatile("" ::: "memory"); }
    }
};
struct EpiMerge {
    static constexpr bool PERM = true, AFTER_DRAIN = false, HOOK = true;
    bf16_t* O; const bf16_t* G; int ldg; int hook_t; int raw;
    __device__ __forceinline__ void hook(f32x4 (&acc)[2][2][4][2], const Unit& u, int wr, int wc, int fr, int fq) const {
        int row0 = u.pm * BM + wr * 64 + fr, col0 = u.pn * BM + wc * 32 + 8 * fq;
        asm volatile("" : "+v"(row0), "+v"(col0));
        u32x4 ga[2][2], gb[2][2];
#pragma unroll
        for (int bj = 0; bj < 2; ++bj) { const bf16_t* gp = G + (size_t)row0 * ldg + col0 + bj * HALF; ga[0][bj] = *(const u32x4*)(gp + 6144); gb[0][bj] = *(const u32x4*)(gp + 8192); }
#pragma unroll
        for (int g = 0; g < 8; ++g) { const int ai = g >> 2, m = g & 3, cb = g & 1, nb_ = cb ^ 1;
            if (g < 7) { const int an = (g + 1) >> 2, mn = (g + 1) & 3;
#pragma unroll
                for (int bj = 0; bj < 2; ++bj) { const bf16_t* gp = G + (size_t)(row0 + an * HALF + mn * 16) * ldg + col0 + bj * HALF; ga[nb_][bj] = *(const u32x4*)(gp + 6144); gb[nb_][bj] = *(const u32x4*)(gp + 8192); } }
#pragma unroll
            for (int bj = 0; bj < 2; ++bj) { f32x4 a0, a1, b0, b1; unpack_bf16x8(ga[cb][bj], a0, a1); unpack_bf16x8(gb[cb][bj], b0, b1);
#pragma unroll
                for (int j = 0; j < 4; ++j) { a0[j] = a0[j] * __builtin_amdgcn_rcpf(fmaxf(b0[j], 1e-30f)); a1[j] = a1[j] * __builtin_amdgcn_rcpf(fmaxf(b1[j], 1e-30f)); }
                acc[ai][bj][m][0] = acc[ai][bj][m][0] * a0; acc[ai][bj][m][1] = acc[ai][bj][m][1] * a1; }
            asm volatile("" ::: "memory"); }
    }
    __device__ __forceinline__ void operator()(const f32x4 (&acc)[2][2][4][2], const Unit& u, int wr, int wc, int fr, int fq) const {
        const int row0 = u.pm * BM + wr * 64 + fr; const int col0 = u.pn * BM + wc * 32 + 8 * fq;
        if (raw) {
#pragma unroll
            for (int ai = 0; ai < 2; ++ai)
#pragma unroll
                for (int m = 0; m < 4; ++m)
#pragma unroll
                    for (int bj = 0; bj < 2; ++bj) { const f32x4 v0 = acc[ai][bj][m][0], v1 = acc[ai][bj][m][1];
                        u32x4 w; w.x = cvt_pk_bf16(v0[0], v0[1]); w.y = cvt_pk_bf16(v0[2], v0[3]); w.z = cvt_pk_bf16(v1[0], v1[1]); w.w = cvt_pk_bf16(v1[2], v1[3]);
                        *(u32x4*)(O + (size_t)(row0 + ai * HALF + m * 16) * 2048 + col0 + bj * HALF) = w; }
            return;
        }
        u32x4 gb[2][2];
#pragma unroll
        for (int bj = 0; bj < 2; ++bj) gb[0][bj] = *(const u32x4*)(G + (size_t)row0 * ldg + 8192 + col0 + bj * HALF);
#pragma unroll
        for (int g = 0; g < 8; ++g) { const int ai = g >> 2, m = g & 3, cb = g & 1, nb_ = cb ^ 1; const size_t row = (size_t)(row0 + ai * HALF + m * 16);
            if (g < 7) { const int an = (g + 1) >> 2, mn = (g + 1) & 3;
#pragma unroll
                for (int bj = 0; bj < 2; ++bj) gb[nb_][bj] = *(const u32x4*)(G + (size_t)(row0 + an * HALF + mn * 16) * ldg + 8192 + col0 + bj * HALF); }
#pragma unroll
            for (int bj = 0; bj < 2; ++bj) { f32x4 b0, b1; unpack_bf16x8(gb[cb][bj], b0, b1);
#pragma unroll
                for (int j = 0; j < 4; ++j) { b0[j] = fmaxf(b0[j], 1e-30f); b1[j] = fmaxf(b1[j], 1e-30f); }
                const f32x4 v0 = acc[ai][bj][m][0] * b0, v1 = acc[ai][bj][m][1] * b1;
                u32x4 w; w.x = cvt_pk_bf16(v0[0], v0[1]); w.y = cvt_pk_bf16(v0[2], v0[3]); w.z = cvt_pk_bf16(v1[0], v1[1]); w.w = cvt_pk_bf16(v1[2], v1[3]);
                *(u32x4*)(O + row * 2048 + col0 + bj * HALF) = w; }
            asm volatile("" ::: "memory"); }
    }
};
struct EpiOutB {
    static constexpr bool PERM = true, AFTER_DRAIN = false, HOOK = false;
    bf16_t* O;
    __device__ __forceinline__ void operator()(const f32x4 (&acc)[2][2][4][2], const Unit& u, int wr, int wc, int fr, int fq) const {
        const int row0 = u.pm * BM + wr * 64 + fr; const int col0 = u.pn * BM + wc * 32 + 8 * fq;
#pragma unroll
        for (int ai = 0; ai < 2; ++ai)
#pragma unroll
            for (int m = 0; m < 4; ++m) { bf16_t* rowp = O + (size_t)(row0 + ai * HALF + m * 16) * 2048 + col0;
#pragma unroll
                for (int bj = 0; bj < 2; ++bj) { const f32x4 v0 = acc[ai][bj][m][0], v1 = acc[ai][bj][m][1];
                    u32x4 w; w.x = cvt_pk_bf16(v0[0], v0[1]); w.y = cvt_pk_bf16(v0[2], v0[3]); w.z = cvt_pk_bf16(v1[0], v1[1]); w.w = cvt_pk_bf16(v1[2], v1[3]);
                    *(u32x4*)(rowp + bj * HALF) = w; } }
    }
};
template <class Epi, class Sched, bool ALIGN_EPI = false, bool SP2 = false>
__device__ __forceinline__ void gemm_phase(PG8_LAS unsigned char* lds, const Gemm g, const Sched& S, const Epi& E) {
    int tid_ = threadIdx.x; asm volatile("" : "+v"(tid_)); const int tid = tid_, wid = __builtin_amdgcn_readfirstlane(tid >> 6), lane = tid & 63, wr = wid >> 2, wc = wid & 3, fr = lane & 15, fq = lane >> 4;
    const int K = g.ld, nt = g.K / BK;
    unsigned voffA[2], voffB[2];
#pragma unroll
    for (int i = 0; i < 2; ++i) { int R, C; stage_rc(tid * 16 + i * 8192, R, C); const int Rb = Epi::PERM ? ((R & ~31) + perm32(R & 31)) : R;
        voffA[i] = (unsigned)(R * K + C) * 2u; voffB[i] = (unsigned)(Rb * K + C) * 2u; }
    const size_t kstep = (size_t)(BK * 2);
    const size_t hstep = (size_t)HALF * K * 2;
    const size_t tstep = 2 * hstep;
    const unsigned ldsw = (unsigned)wid * 1024u;
    const int aoff = lds_byte(wr * 64 + fr, fq * 8), boff = lds_byte(wc * 32 + fr, fq * 8);
#define PG8_SA(b, h) (((b) * 2 + (h)) * HTB)
#define PG8_SB(b, h) ((4 + (b) * 2 + (h)) * HTB)
#define PG8_STAGE(bufoff, gbase, voff) do { _Pragma("unroll") for (int _i = 0; _i < 2; ++_i) \
        __builtin_amdgcn_global_load_lds((const unsigned*)((const char*)(gbase) + (voff)[_i]), (PG8_LAS unsigned*)(lds + (bufoff) + ldsw + _i * 8192), 16, 0, 0); } while (0)
#define PG8_LDA(dst, b, h) do { _Pragma("unroll") for (int m = 0; m < 4; ++m) _Pragma("unroll") for (int k = 0; k < 2; ++k) dst[m][k] = *(const PG8_LAS bf16x8*)(lds + PG8_SA(b, h) + aoff + m * 2048 + k * 1024); } while (0)
#define PG8_LDB(dst, b, h) do { _Pragma("unroll") for (int n = 0; n < 2; ++n) _Pragma("unroll") for (int k = 0; k < 2; ++k) dst[n][k] = *(const PG8_LAS bf16x8*)(lds + PG8_SB(b, h) + boff + n * 2048 + k * 1024); } while (0)
#define PG8_MMA(ai, bj, At, Bt) do { __builtin_amdgcn_s_setprio(1); _Pragma("unroll") for (int m = 0; m < 4; ++m) _Pragma("unroll") for (int n = 0; n < 2; ++n) _Pragma("unroll") for (int k = 0; k < 2; ++k) \
        acc[ai][bj][m][n] = __builtin_amdgcn_mfma_f32_16x16x32_bf16(Bt[n][k], At[m][k], acc[ai][bj][m][n], 0, 0, 0); __builtin_amdgcn_s_setprio(0); } while (0)
#define PG8_WAIT_V(n) asm volatile("s_waitcnt vmcnt(" #n ")" ::: "memory")
#define PG8_WAIT_L(n) asm volatile("s_waitcnt lgkmcnt(" #n ")" ::: "memory")
#define PG8_BAR __builtin_amdgcn_s_barrier()
#define PG8_SCHED __builtin_amdgcn_sched_barrier(0)
    Unit cur, nxt; int ui = 0;
    if (!S.next(0, cur)) return;
    f32x4 acc[2][2][4][2];
#pragma unroll
    for (int a = 0; a < 2; ++a)
#pragma unroll
        for (int b = 0; b < 2; ++b)
#pragma unroll
            for (int m = 0; m < 4; ++m)
#pragma unroll
                for (int n = 0; n < 2; ++n) acc[a][b][m][n] = (f32x4){0.f, 0.f, 0.f, 0.f};
    bf16x8 At[4][2], B0[2][2], B1[2][2];
    const char* cA = (const char*)g.A + (size_t)cur.pm * tstep; const char* cB = (const char*)g.Bt + (size_t)cur.pn * tstep;
    S.a_ready(cur);
    if constexpr (SP2) {
        PG8_STAGE(PG8_SB(0, 0), cB, voffB); PG8_STAGE(PG8_SB(0, 1), cB + hstep, voffB); PG8_STAGE(PG8_SA(0, 0), cA, voffA); PG8_STAGE(PG8_SA(0, 1), cA + hstep, voffA);
        if (wr == 1) PG8_BAR;
        PG8_WAIT_V(2); PG8_BAR;
        PG8_STAGE(PG8_SB(1, 0), cB + kstep, voffB); PG8_STAGE(PG8_SA(1, 0), cA + kstep, voffA); PG8_STAGE(PG8_SB(1, 1), cB + hstep + kstep, voffB);
        PG8_WAIT_V(6); PG8_BAR;
    } else {
        PG8_STAGE(PG8_SB(0, 0), cB, voffB); PG8_STAGE(PG8_SA(0, 0), cA, voffA); PG8_STAGE(PG8_SB(0, 1), cB + hstep, voffB); PG8_STAGE(PG8_SA(0, 1), cA + hstep, voffA);
        if (wr == 1) PG8_BAR;
        PG8_WAIT_V(4); PG8_BAR;
        PG8_STAGE(PG8_SB(1, 0), cB + kstep, voffB); PG8_STAGE(PG8_SA(1, 0), cA + kstep, voffA); PG8_STAGE(PG8_SB(1, 1), cB + hstep + kstep, voffB);
        PG8_WAIT_V(6); PG8_BAR;
    }
    for (;;) {
        const bool has_next = S.next(ui + 1, nxt);
        const char* nA = has_next ? (const char*)g.A + (size_t)nxt.pm * tstep : cA; const char* nB = has_next ? (const char*)g.Bt + (size_t)nxt.pn * tstep : cB;
        for (int t = 0; t < nt; t += 2) {
            if constexpr (Epi::HOOK) { if (t == E.hook_t) E.hook(acc, cur, wr, wc, fr, fq); }
            const bool last = (t == nt - 2);
            const char* a1 = cA + (size_t)(t + 1) * kstep;
            const char* a2 = last ? nA : cA + (size_t)(t + 2) * kstep; const char* b2 = last ? nB : cB + (size_t)(t + 2) * kstep;
            const char* a3 = a2 + kstep; const char* b3 = b2 + kstep;
            if (last && has_next) S.a_ready(nxt);
            if constexpr (SP2) {
            PG8_LDB(B0, 0, 0); PG8_LDB(B1, 0, 1); PG8_SCHED; PG8_LDA(At, 0, 0); PG8_STAGE(PG8_SA(1, 1), a1 + hstep, voffA);
            PG8_WAIT_V(8); PG8_WAIT_L(0); PG8_BAR; PG8_MMA(0, 0, At, B0); PG8_MMA(0, 1, At, B1); PG8_BAR; PG8_SCHED;
            PG8_LDA(At, 0, 1); PG8_STAGE(PG8_SB(0, 0), b2, voffB); PG8_STAGE(PG8_SB(0, 1), b2 + hstep, voffB); PG8_STAGE(PG8_SA(0, 0), a2, voffA);
            PG8_WAIT_V(8); PG8_WAIT_L(0); PG8_BAR; PG8_MMA(1, 0, At, B0); PG8_MMA(1, 1, At, B1); PG8_BAR; PG8_SCHED;
            PG8_LDB(B0, 1, 0); PG8_LDB(B1, 1, 1); PG8_SCHED; PG8_LDA(At, 1, 0); PG8_STAGE(PG8_SA(0, 1), a2 + hstep, voffA);
            PG8_WAIT_V(8); PG8_WAIT_L(0); PG8_BAR; PG8_MMA(0, 0, At, B0); PG8_MMA(0, 1, At, B1); PG8_BAR; PG8_SCHED;
            PG8_LDA(At, 1, 1); PG8_STAGE(PG8_SB(1, 0), b3, voffB); PG8_STAGE(PG8_SB(1, 1), b3 + hstep, voffB); PG8_STAGE(PG8_SA(1, 0), a3, voffA);
            PG8_WAIT_V(8); PG8_WAIT_L(0); PG8_BAR; PG8_MMA(1, 0, At, B0); PG8_MMA(1, 1, At, B1); PG8_BAR; PG8_SCHED;
            } else {
            PG8_LDB(B0, 0, 0); PG8_SCHED; PG8_LDA(At, 0, 0); PG8_STAGE(PG8_SA(1, 1), a1 + hstep, voffA);
            PG8_WAIT_L(8); PG8_BAR; PG8_WAIT_L(0); PG8_MMA(0, 0, At, B0); PG8_BAR; PG8_SCHED;
            PG8_LDB(B1, 0, 1); PG8_STAGE(PG8_SB(0, 0), b2, voffB);
            PG8_BAR; PG8_WAIT_L(0); PG8_MMA(0, 1, At, B1); PG8_BAR;
            PG8_LDA(At, 0, 1); PG8_STAGE(PG8_SA(0, 0), a2, voffA);
            PG8_BAR; PG8_WAIT_L(0); PG8_MMA(1, 0, At, B0); PG8_BAR; PG8_SCHED;
            PG8_STAGE(PG8_SB(0, 1), b2 + hstep, voffB);
            PG8_WAIT_V(6); PG8_BAR; PG8_MMA(1, 1, At, B1); PG8_BAR;
            PG8_LDB(B0, 1, 0); PG8_SCHED; PG8_LDA(At, 1, 0); PG8_STAGE(PG8_SA(0, 1), a2 + hstep, voffA);
            PG8_WAIT_L(8); PG8_BAR; PG8_WAIT_L(0); PG8_MMA(0, 0, At, B0); PG8_BAR; PG8_SCHED;
            PG8_LDB(B1, 1, 1); PG8_STAGE(PG8_SB(1, 0), b3, voffB);
            PG8_BAR; PG8_WAIT_L(0); PG8_MMA(0, 1, At, B1); PG8_BAR;
            PG8_LDA(At, 1, 1); PG8_STAGE(PG8_SA(1, 0), a3, voffA);
            PG8_BAR; PG8_WAIT_L(0); PG8_MMA(1, 0, At, B0); PG8_BAR; PG8_SCHED;
            PG8_STAGE(PG8_SB(1, 1), b3 + hstep, voffB);
            PG8_WAIT_V(6); PG8_BAR; PG8_MMA(1, 1, At, B1); PG8_BAR;
            }
        }
        if constexpr (ALIGN_EPI) { if (wr == 0) PG8_BAR; }
        if constexpr (!Epi::AFTER_DRAIN) { E(acc, cur, wr, wc, fr, fq); S.done(cur); }
        if (!has_next) break;
#pragma unroll
        for (int a = 0; a < 2; ++a)
#pragma unroll
            for (int b = 0; b < 2; ++b)
#pragma unroll
                for (int m = 0; m < 4; ++m)
#pragma unroll
                    for (int n = 0; n < 2; ++n) acc[a][b][m][n] = (f32x4){0.f, 0.f, 0.f, 0.f};
        cur = nxt; cA = nA; cB = nB; ++ui;
        if constexpr (ALIGN_EPI) { if (wr == 1) PG8_BAR; }
    }
    PG8_WAIT_V(0);
    if constexpr (!ALIGN_EPI) { if (wr == 0) PG8_BAR; }
    PG8_BAR;
    if constexpr (Epi::AFTER_DRAIN) { E.fused(acc, cur, wr, wc, fr, fq, lds, wid, lane); S.done(cur); }
#undef PG8_SA
#undef PG8_SB
#undef PG8_STAGE
#undef PG8_LDA
#undef PG8_LDB
#undef PG8_MMA
#undef PG8_WAIT_V
#undef PG8_WAIT_L
#undef PG8_BAR
#undef PG8_SCHED
}
}

#define LAS __attribute__((address_space(3)))
typedef unsigned short bf16;
typedef unsigned v4u __attribute__((ext_vector_type(4)));
typedef unsigned v2u __attribute__((ext_vector_type(2)));
typedef float f32x4 __attribute__((ext_vector_type(4)));
typedef short bf16x8 __attribute__((ext_vector_type(8)));
constexpr int NWAVES = 8, NTHR = 512;
constexpr int DM = 2048, NP = 8192, NS = 1024, MT = NP + NS;
constexpr int NC = 10240, PW = 1024, LW = 2048;
constexpr int C_UA = 0, C_GA = 1024, C_UB = 2048, C_GB = 4096, C_MA = 6144, C_MB = 8192;
constexpr int NCHUNK = 32;
constexpr float LN_EPS = 1e-5f;
constexpr float DN_ALPHA = 1.41421356237309515f;
constexpr int LDS_MISC = 139264;
constexpr int LDS_JUNK = 131072 + 256;
constexpr int LDS_BYTES = 131072 + 256 + 8192;
constexpr size_t SZ_WIN = (size_t)NC * DM * 2, SZ_WPA = (size_t)DM * PW * 2, SZ_WPB = (size_t)DM * LW * 2, SZ_WOUT = (size_t)DM * DM * 2;
constexpr size_t SZ_POOLW = (size_t)4 * 256 * 256 * 2, SZ_LRUW = (size_t)16 * 128 * 128 * 2;
constexpr size_t WS_WIN = 0;
constexpr size_t WS_WPA = WS_WIN + 2 * SZ_WIN;
constexpr size_t WS_WPB = WS_WPA + 2 * SZ_WPA;
constexpr size_t WS_WOUT = WS_WPB + 2 * SZ_WPB;
constexpr int KCAT = PW + LW;
constexpr size_t WS_WCAT = WS_WPA, SZ_WCAT = (size_t)DM * KCAT * 2;
static_assert(2 * SZ_WCAT == 2 * SZ_WPA + 2 * SZ_WPB, "WCAT overlay");
constexpr size_t WS_POOLW = WS_WOUT + 2 * SZ_WOUT;
constexpr size_t WS_WA = WS_POOLW + 2 * SZ_POOLW;
constexpr size_t WS_WX = WS_WA + 2 * SZ_LRUW;
constexpr size_t WS_C8 = WS_WX + 2 * SZ_LRUW;
constexpr size_t WS_XB = WS_C8 + 2 * 2048 * 4;
constexpr size_t WS_PROJ = WS_XB + (size_t)MT * DM * 2;
constexpr size_t WS_YA = WS_PROJ + (size_t)MT * NC * 2;
constexpr size_t WS_YB = WS_YA + (size_t)MT * PW * 2;
constexpr size_t WS_HL = WS_YB + (size_t)MT * LW * 2;
constexpr size_t WS_PP = WS_HL + (size_t)MT * LW * 4;
constexpr size_t WS_TOT = WS_PP + (size_t)MT * LW * 4;
constexpr size_t WS_TMP = WS_TOT + (size_t)2 * 4 * NCHUNK * LW * 4;
constexpr size_t WS_CTL = WS_TMP + (size_t)MT * DM * 4;
constexpr size_t WS_TOT2 = WS_CTL + 16384;
constexpr size_t WS_PREF2 = WS_TOT2 + (size_t)4 * NCHUNK * LW * 8;
constexpr size_t CTL_BYTES = 16384 + (size_t)4 * NCHUNK * LW * 12;
constexpr size_t WS_END = WS_CTL + CTL_BYTES;
constexpr size_t O_Y = 0;
constexpr size_t O_POOLP = (size_t)MT * DM;
constexpr size_t O_CONVP = O_POOLP + (size_t)2 * 4 * 15 * PW;
constexpr size_t O_HP = O_CONVP + (size_t)2 * 4 * 3 * LW;
constexpr size_t O_POOLS = O_HP + (size_t)2 * 4 * LW;
constexpr size_t O_CONVS = O_POOLS + (size_t)2 * 128 * 15 * PW;
constexpr size_t O_HS = O_CONVS + (size_t)2 * 128 * 3 * LW;
constexpr size_t O_END = O_HS + (size_t)2 * 128 * LW;

#ifndef DUP_P0
#define DUP_P0 0
#endif
#ifndef DUP_G1
#define DUP_G1 0
#endif
#ifndef DUP_MIX
#define DUP_MIX 0
#endif
#ifndef DUP_FIX
#define DUP_FIX 0
#endif
#ifndef DUP_MERGE
#define DUP_MERGE 0
#endif
#ifndef DUP_OUT0
#define DUP_OUT0 0
#endif
struct Params { const float* in[21]; float* out; unsigned char* ws; int ph_lo, ph_hi; };

#define LDS_WAIT() asm volatile("s_waitcnt lgkmcnt(0)" ::: "memory")
__device__ __forceinline__ unsigned f2bf(float f) { unsigned u = __builtin_bit_cast(unsigned, f); return (u + 0x7fffu + ((u >> 16) & 1u)) >> 16; }
__device__ __forceinline__ unsigned pk2(float lo, float hi) { return f2bf(lo) | (f2bf(hi) << 16); }
__device__ __forceinline__ float bflo(unsigned w) { return __uint_as_float(w << 16); }
__device__ __forceinline__ float bfhi(unsigned w) { return __uint_as_float(w & 0xffff0000u); }
__device__ __forceinline__ float wave_sum(float v) {
#pragma unroll
    for (int o = 1; o < 64; o <<= 1) v += __shfl_xor(v, o);
    return v;
}

__device__ __forceinline__ void p0_transpose_item(const float* W, int K, int N, bf16* WT, LAS float* scr, int item, int lane, int ldw = 0, int koff = 0) {
    if (ldw == 0) ldw = K;
    const int nblk = N / 32, kb = item / nblk, nb = item % nblk, k0 = 64 * kb, n0 = 32 * nb;
    float tv_[32];
#pragma unroll
    for (int i = 0; i < 32; ++i) tv_[i] = W[(size_t)(k0 + 2 * i + (lane >> 5)) * N + n0 + (lane & 31)];
#pragma unroll
    for (int i = 0; i < 32; ++i) scr[(2 * i + (lane >> 5)) * 33 + (lane & 31)] = tv_[i];
    LDS_WAIT(); asm volatile("" ::: "memory");
    const int c = lane & 7;
#pragma unroll
    for (int j = 0; j < 4; ++j) { const int n = (lane >> 3) + 8 * j; const LAS float* s = scr + (8 * c) * 33 + n;
        v4u o; o.x = pk2(s[0 * 33], s[1 * 33]); o.y = pk2(s[2 * 33], s[3 * 33]); o.z = pk2(s[4 * 33], s[5 * 33]); o.w = pk2(s[6 * 33], s[7 * 33]);
        *(v4u*)(WT + (size_t)(n0 + n) * ldw + koff + k0 + 8 * c) = o; }
    LDS_WAIT(); asm volatile("" ::: "memory");
}
constexpr int I_IN = (DM / 64) * (NC / 32), I_PA = (PW / 64) * (DM / 32), I_PB = (LW / 64) * (DM / 32), I_OUT = (DM / 64) * (DM / 32);
constexpr int I_PL = 8 * (256 / 64) * (256 / 32), I_LR = 32 * (128 / 64) * (128 / 32);
constexpr int IT_IN = 0, IT_PA = 2 * I_IN, IT_PB = IT_PA + 2 * I_PA, IT_OUT = IT_PB + 2 * I_PB, IT_SMALL = IT_OUT + 2 * I_OUT, IT_END = IT_SMALL + I_PL + 2 * I_LR;
__device__ __forceinline__ void convert_range(LAS unsigned char* lds, const Params& p, const int lo, const int hi, const int gw, const int NGW) {
    int tid_ = threadIdx.x; asm volatile("" : "+v"(tid_)); const int lane = tid_ & 63, wave = tid_ >> 6;
    LAS float* scr = (LAS float*)(lds + wave * 16384);
    unsigned char* ws = p.ws; asm volatile("" : "+s"(ws));
    for (int it = lo + gw; it < hi; it += NGW) {
        int r = it;
        if (r < 2 * I_IN) { const int l = r / I_IN; r -= l * I_IN; p0_transpose_item(p.in[5] + (size_t)l * DM * NC, DM, NC, (bf16*)(ws + WS_WIN + l * SZ_WIN), scr, r, lane); continue; } r -= 2 * I_IN;
        if (r < 2 * I_PA) { const int l = r / I_PA; r -= l * I_PA; p0_transpose_item(p.in[16] + (size_t)l * PW * DM, PW, DM, (bf16*)(ws + WS_WCAT + l * SZ_WCAT), scr, r, lane, KCAT, 0); continue; } r -= 2 * I_PA;
        if (r < 2 * I_PB) { const int l = r / I_PB; r -= l * I_PB; p0_transpose_item(p.in[17] + (size_t)l * LW * DM, LW, DM, (bf16*)(ws + WS_WCAT + l * SZ_WCAT), scr, r, lane, KCAT, PW); continue; } r -= 2 * I_PB;
        if (r < 2 * I_OUT) { const int l = r / I_OUT; r -= l * I_OUT; p0_transpose_item(p.in[18] + (size_t)l * DM * DM, DM, DM, (bf16*)(ws + WS_WOUT + l * SZ_WOUT), scr, r, lane); continue; } r -= 2 * I_OUT;
        if (r < I_PL) { const int mi = r / 32; r -= mi * 32; p0_transpose_item(p.in[7] + (size_t)mi * 65536, 256, 256, (bf16*)(ws + WS_POOLW) + (size_t)mi * 65536, scr, r, lane); continue; } r -= I_PL;
        if (r < I_LR) { const int mi = r / 8; r -= mi * 8; p0_transpose_item(p.in[11] + (size_t)mi * 16384, 128, 128, (bf16*)(ws + WS_WA) + (size_t)mi * 16384, scr, r, lane); continue; } r -= I_LR;
        { const int mi = r / 8; r -= mi * 8; p0_transpose_item(p.in[13] + (size_t)mi * 16384, 128, 128, (bf16*)(ws + WS_WX) + (size_t)mi * 16384, scr, r, lane); }
    }
}
__device__ __forceinline__ void p0_prologue(LAS unsigned char* lds, const Params& p) {
    int tid_ = threadIdx.x; asm volatile("" : "+v"(tid_)); const int tid = tid_, lane = tid & 63, wave = tid >> 6;
    const int gw = blockIdx.x * NWAVES + wave, NGW = gridDim.x * NWAVES;
    unsigned char* ws = p.ws; asm volatile("" : "+s"(ws));
    if (gridDim.x == 256) { convert_range(lds, p, IT_IN, IT_IN + I_IN, gw, NGW); convert_range(lds, p, IT_SMALL, IT_END, gw, NGW); }
    else convert_range(lds, p, 0, IT_END, gw, NGW);
    bf16* XB = (bf16*)(ws + WS_XB);
    for (int m = gw; m < MT; m += NGW) {
        const float* xr = (m < NP) ? p.in[0] + (size_t)m * DM : p.in[1] + (size_t)(m - NP) * DM;
        unsigned long long* o8 = (unsigned long long*)(XB + (size_t)m * DM) + lane;
#pragma unroll
        for (int j = 0; j < 8; ++j) { const f32x4 v = *((const f32x4*)xr + lane + 64 * j); o8[64 * j] = (unsigned long long)pk2(v.x, v.y) | ((unsigned long long)pk2(v.z, v.w) << 32); }
    }
    float* C8 = (float*)(ws + WS_C8);
    for (int i = blockIdx.x * NTHR + tid; i < 2 * LW; i += gridDim.x * NTHR) { const float x = -p.in[15][i]; C8[i] = 8.0f * (fmaxf(x, 0.f) + log1pf(expf(-fabsf(x)))); }
}

__device__ __forceinline__ void state_copies(const Params& p, const int layer, const int wg_id, const int n_wg) {
    int tid_ = threadIdx.x; asm volatile("" : "+v"(tid_)); const int tid = tid_;
    unsigned char* ws = p.ws; asm volatile("" : "+s"(ws));
    const bf16* PROJ = (const bf16*)(ws + WS_PROJ); float* out = p.out;
    const int gt = wg_id * NTHR + tid, GT = n_wg * NTHR;
    constexpr int N_PP = 4 * 15 * (PW / 4), N_CP = 4 * 3 * (LW / 4), N_PS = 128 * 15 * (PW / 4), N_CS = 128 * 3 * (LW / 4), N_ST = N_PP + N_CP + N_PS + N_CS;
    for (int it0 = gt; it0 < N_ST; it0 += 3 * GT) {
        const bf16* src[3]; const float* fsrc[3]; float* dst[3]; bool isf[3], ok[3];
#pragma unroll
        for (int k = 0; k < 3; ++k) {
            const int it = it0 + k * GT; ok[k] = it < N_ST; int r = ok[k] ? it : 0; isf[k] = false; src[k] = PROJ; fsrc[k] = p.in[2];
            if (r < N_PP) { const int c4 = r % (PW / 4), i = (r / (PW / 4)) % 15, b_ = r / (15 * (PW / 4));
                src[k] = PROJ + (size_t)(b_ * 2048 + 2033 + i) * NC + C_UA + c4 * 4; dst[k] = out + O_POOLP + ((size_t)(layer * 4 + b_) * 15 + i) * PW + c4 * 4; }
            else if ((r -= N_PP) < N_CP) { const int c4 = r % (LW / 4), i = (r / (LW / 4)) % 3, b_ = r / (3 * (LW / 4));
                src[k] = PROJ + (size_t)(b_ * 2048 + 2045 + i) * NC + C_UB + c4 * 4; dst[k] = out + O_CONVP + ((size_t)(layer * 4 + b_) * 3 + i) * LW + c4 * 4; }
            else if ((r -= N_CP) < N_PS) { const int c4 = r % (PW / 4), i = (r / (PW / 4)) % 15, bs = r / (15 * (PW / 4));
                dst[k] = out + O_POOLS + ((size_t)(layer * 128 + bs) * 15 + i) * PW + c4 * 4;
                if (i < 7) { isf[k] = true; fsrc[k] = p.in[2] + ((size_t)(layer * 128 + bs) * 15 + 8 + i) * PW + c4 * 4; } else src[k] = PROJ + (size_t)(NP + bs * 8 + (i - 7)) * NC + C_UA + c4 * 4; }
            else { r -= N_PS; const int c4 = r % (LW / 4), i = (r / (LW / 4)) % 3, bs = r / (3 * (LW / 4));
                src[k] = PROJ + (size_t)(NP + bs * 8 + 5 + i) * NC + C_UB + c4 * 4; dst[k] = out + O_CONVS + ((size_t)(layer * 128 + bs) * 3 + i) * LW + c4 * 4; }
        }
        v2u wv[3]; f32x4 fv[3];
#pragma unroll
        for (int k = 0; k < 3; ++k) { wv[k] = *(const v2u*)src[k]; fv[k] = *(const f32x4*)fsrc[k]; }
#pragma unroll
        for (int k = 0; k < 3; ++k) { const f32x4 v = isf[k] ? fv[k] : (f32x4){bflo(wv[k].x), bfhi(wv[k].x), bflo(wv[k].y), bfhi(wv[k].y)}; if (ok[k]) *(f32x4*)dst[k] = v; }
    }
}

__device__ __forceinline__ float mix_sigmoid(float v) { return __builtin_amdgcn_rcpf(1.0f + __expf(-v)); }
__device__ __forceinline__ float one_minus_exp(float x) {
    const float q = 1.f + x * (0.5f + x * (1.f / 6 + x * (1.f / 24 + x * (1.f / 120 + x * (1.f / 720 + x * (1.f / 5040))))));
    return (x > -0.3f) ? -x * q : 1.0f - __expf(x);
}
#define BF8_TO_F32(vw, lo, hi) const f32x4 lo = {bflo(vw.x), bfhi(vw.x), bflo(vw.y), bfhi(vw.y)}, hi = {bflo(vw.z), bfhi(vw.z), bflo(vw.w), bfhi(vw.w)}
#define RLX_AGENT __ATOMIC_RELAXED, __HIP_MEMORY_SCOPE_AGENT
__device__ __forceinline__ int mix_tile_row0(int s) { return s < 128 ? (s & 3) * 2048 + (s >> 2) * 64 : NP + (s - 128) * 64; }
__device__ __forceinline__ void mix_phase(LAS unsigned char* lds, const Params& p, const int layer) {
    int tid_ = threadIdx.x; asm volatile("" : "+v"(tid_)); const int tid = tid_, wid = __builtin_amdgcn_readfirstlane(tid >> 6), lane = tid & 63, fr = lane & 15, fq = lane >> 4;
    unsigned char* ws = p.ws; asm volatile("" : "+s"(ws));
    const bf16* PROJ = (const bf16*)(ws + WS_PROJ);
    float* out = p.out;
    const int G = (int)gridDim.x;
    constexpr int NUA = 288 * 4, NUB = 144 * 16;
    {
        LAS float* XC3 = (LAS float*)lds;
        LAS bf16* At2 = (LAS bf16*)(lds + 3 * 33792);
        LAS float* CWL = (LAS float*)(lds + 3 * 33792 + 2 * 17408);
        const int cw = wid * 16;
        const int q16 = tid & 15, yrow = tid >> 3, yc16 = (tid & 7) * 16;
        bf16x8 ba[4], bx[4]; float bav = 0.f, bxv = 0.f, c8v = 0.f;
        v4u pre[2][4];
#define MIX_PREFETCH_B(uu) do { const int s__ = (uu) >> 4, nb__ = (uu) & 15, r0__ = mix_tile_row0(s__); \
        if (s__ < 128) { _Pragma("unroll") for (int i__ = 0; i__ < 2; ++i__) { const int r__ = r0__ + (tid >> 4) + 32 * i__, t__ = r__ & 2047; const bf16* src__ = PROJ + (size_t)r__ * NC + C_UB + nb__ * 128 + q16 * 8; \
            _Pragma("unroll") for (int k__ = 0; k__ < 4; ++k__) { const int jb__ = 3 - k__; pre[i__][k__] = *(const v4u*)(src__ - ((jb__ <= t__) ? (size_t)jb__ * NC : 0)); } } } } while (0)
        const int u0 = (int)blockIdx.x;
        if (u0 < NUB) {
            const int nb = u0 & 15, c0 = nb * 128, ch = c0 + cw + fr;
            { const bf16* WA = (const bf16*)(ws + WS_WA) + (size_t)(layer * 16 + nb) * 16384 + (size_t)(cw + fr) * 128 + fq * 8;
              const bf16* WX = (const bf16*)(ws + WS_WX) + (size_t)(layer * 16 + nb) * 16384 + (size_t)(cw + fr) * 128 + fq * 8;
#pragma unroll
              for (int ks = 0; ks < 4; ++ks) { ba[ks] = *(const bf16x8*)(WA + ks * 32); bx[ks] = *(const bf16x8*)(WX + ks * 32); }
              bav = p.in[12][layer * LW + ch]; bxv = p.in[14][layer * LW + ch]; c8v = ((const float*)(ws + WS_C8))[layer * LW + ch]; }
            MIX_PREFETCH_B(u0);
            __syncthreads();
            for (int i = tid; i < 5 * 128; i += NTHR) { const int k = i >> 7, cc = i & 127; CWL[i] = (k == 0) ? p.in[10][(size_t)layer * LW + c0 + cc] : p.in[9][((size_t)layer * 4 + (k - 1)) * LW + c0 + cc]; }
            __syncthreads();
            {
                const int r0N = mix_tile_row0(u0 >> 4); const bool prtN = (u0 >> 4) < 128; LAS float* XCN = XC3; LAS bf16* AtN = At2;
            if (prtN) {
                const f32x4 cb0 = *(const LAS f32x4*)(CWL + q16 * 8), cb1 = *(const LAS f32x4*)(CWL + q16 * 8 + 4);
#pragma unroll
                for (int i = 0; i < 2; ++i) {
                    const int rl = (tid >> 4) + 32 * i, t = (r0N + rl) & 2047;
                    f32x4 x0 = cb0, x1 = cb1;
#pragma unroll
                    for (int k = 0; k < 4; ++k) { const float f = ((3 - k) <= t) ? 1.0f : 0.0f;
                        const f32x4 w0 = *(const LAS f32x4*)(CWL + (k + 1) * 128 + q16 * 8), w1 = *(const LAS f32x4*)(CWL + (k + 1) * 128 + q16 * 8 + 4);
                        BF8_TO_F32(pre[i][k], a0, a1); x0 += w0 * (a0 * f); x1 += w1 * (a1 * f); }
                    *(LAS f32x4*)(XCN + rl * 132 + q16 * 8) = x0; *(LAS f32x4*)(XCN + rl * 132 + q16 * 8 + 4) = x1;
                    v4u o; o.x = pk2(x0[0], x0[1]); o.y = pk2(x0[2], x0[3]); o.z = pk2(x1[0], x1[1]); o.w = pk2(x1[2], x1[3]);
                    *(LAS v4u*)(AtN + rl * 136 + q16 * 8) = o;
                }
            } else {
                const float* sconv = p.in[3] + (size_t)layer * 128 * 3 * LW;
#pragma unroll 1
                for (int i = 0; i < 2; ++i) {
                    const int rl = (tid >> 4) + 32 * i, r = r0N + rl, c = c0 + q16 * 8, t = (r - NP) & 7, bs = (r - NP) >> 3;
                    f32x4 x0 = *(const LAS f32x4*)(CWL + q16 * 8), x1 = *(const LAS f32x4*)(CWL + q16 * 8 + 4);
#pragma unroll
                    for (int k = 0; k < 4; ++k) { const int jb = 3 - k;
                        const f32x4 w0 = *(const LAS f32x4*)(CWL + (k + 1) * 128 + q16 * 8), w1 = *(const LAS f32x4*)(CWL + (k + 1) * 128 + q16 * 8 + 4);
                        if (jb <= t) { const v4u vw = *(const v4u*)(PROJ + (size_t)(r - jb) * NC + C_UB + c); BF8_TO_F32(vw, a0, a1); x0 += w0 * a0; x1 += w1 * a1; }
                        else { const float* sp = sconv + ((size_t)bs * 3 + (3 + t - jb)) * LW + c; x0 += w0 * *(const f32x4*)sp; x1 += w1 * *(const f32x4*)(sp + 4); }
                    }
                    *(LAS f32x4*)(XCN + rl * 132 + q16 * 8) = x0; *(LAS f32x4*)(XCN + rl * 132 + q16 * 8 + 4) = x1;
                    v4u o; o.x = pk2(x0[0], x0[1]); o.y = pk2(x0[2], x0[3]); o.z = pk2(x1[0], x1[1]); o.w = pk2(x1[2], x1[3]);
                    *(LAS v4u*)(AtN + rl * 136 + q16 * 8) = o;
                }
            }
            }
            if (u0 + G < NUB) MIX_PREFETCH_B(u0 + G);
            __syncthreads();
            int xb = 0, ab = 0;
            for (int u = u0; u < NUB; u += G) {
                const int s_ = u >> 4, r0 = mix_tile_row0(s_);
                const bool prt = s_ < 128;
                LAS float* XC = XC3 + xb * (33792 / 4); LAS bf16* At = At2 + ab * (17408 / 2);
                const int xbn = (xb == 2) ? 0 : xb + 1, abn = ab ^ 1;
                const v4u sgc0 = *(const v4u*)(PROJ + (size_t)(r0 + yrow) * NC + C_GB + c0 + yc16), sgc1 = *(const v4u*)(PROJ + (size_t)(r0 + yrow) * NC + C_GB + c0 + yc16 + 8);
            f32x4 accr[4], acci[4];
#pragma unroll
            for (int m = 0; m < 4; ++m) { accr[m] = (f32x4){0.f, 0.f, 0.f, 0.f}; acci[m] = (f32x4){0.f, 0.f, 0.f, 0.f}; }
#pragma unroll
            for (int ks = 0; ks < 4; ++ks)
#pragma unroll
                for (int m = 0; m < 4; ++m) { const bf16x8 a = *(const LAS bf16x8*)(At + (m * 16 + fr) * 136 + ks * 32 + fq * 8);
                    accr[m] = __builtin_amdgcn_mfma_f32_16x16x32_bf16(a, ba[ks], accr[m], 0, 0, 0);
                    acci[m] = __builtin_amdgcn_mfma_f32_16x16x32_bf16(a, bx[ks], acci[m], 0, 0, 0); }
            float hl[4][4], pl[4][4];
            float Hc = 0.f, Pc = 1.f;
            const int gq = prt ? fq : (fq & 1);
            float h0s[4] = {0.f, 0.f, 0.f, 0.f};
            if (!prt) {
#pragma unroll
                for (int m = 0; m < 4; ++m) h0s[m] = p.in[4][(size_t)(layer * 128 + ((r0 - NP) >> 3) + 2 * m + (fq >> 1)) * LW + ch];
            }
#pragma unroll
            for (int m = 0; m < 4; ++m) {
                float h_[4], P_[4];
#pragma unroll
                for (int j = 0; j < 4; ++j) { const float xa = XC[(m * 16 + fq * 4 + j) * 132 + cw + fr];
                    const float rg = mix_sigmoid(accr[m][j] + bav), ig = mix_sigmoid(acci[m][j] + bxv), la = -rg * c8v, x2 = 2.0f * la;
                    const float Pj = __expf(la);
                    const float q_ = 1.f + x2 * (0.5f + x2 * (1.f / 6 + x2 * (1.f / 24 + x2 * (1.f / 120 + x2 * (1.f / 720 + x2 * (1.f / 5040))))));
                    const float om = (x2 > -0.3f) ? -x2 * q_ : 1.0f - Pj * Pj;
                    P_[j] = Pj; h_[j] = __builtin_amdgcn_sqrtf(om) * (ig * xa); }
#pragma unroll
                for (int j = 1; j < 4; ++j) { h_[j] = P_[j] * h_[j - 1] + h_[j]; P_[j] = P_[j] * P_[j - 1]; }
                float Pg = P_[3], Hg = h_[3];
                { const float Pu = __shfl_up(Pg, 16), Hu = __shfl_up(Hg, 16); if (gq >= 1) { Hg = Pg * Hu + Hg; Pg = Pg * Pu; } }
                { const float Pu = __shfl_up(Pg, 32), Hu = __shfl_up(Hg, 32); if (gq >= 2) { Hg = Pg * Hu + Hg; Pg = Pg * Pu; } }
                float Pe = __shfl_up(Pg, 16), He = __shfl_up(Hg, 16); if (gq == 0) { Pe = 1.f; He = 0.f; }
                const float Hcm = prt ? Hc : h0s[m];
                const float Hin = Pe * Hcm + He, Pin = Pe * Pc;
#pragma unroll
                for (int j = 0; j < 4; ++j) { hl[m][j] = h_[j] + P_[j] * Hin; pl[m][j] = P_[j] * Pin; }
                const float hb = __shfl(hl[m][3], 48 + fr), pb_ = __shfl(pl[m][3], 48 + fr);
                Hc = prt ? hb : 0.f; Pc = prt ? pb_ : 1.f;
            }
            if (!prt && (fq & 1)) {
#pragma unroll
                for (int m = 0; m < 4; ++m) out[O_HS + (size_t)(layer * 128 + ((r0 - NP) >> 3) + 2 * m + (fq >> 1)) * LW + ch] = hl[m][3];
            }
                if (prt) {
                const int b_ = r0 >> 11, c_ = (r0 & 2047) >> 6;
                const unsigned tag = (unsigned)layer + 1u;
                unsigned long long* T1 = (unsigned long long*)(ws + WS_TOT2) + (size_t)(b_ * 32) * LW + ch;
                unsigned* PF = (unsigned*)(ws + WS_PREF2) + (size_t)(b_ * 32) * LW + ch;
                if (fq == 0) __hip_atomic_store(T1 + (size_t)c_ * LW, ((unsigned long long)__float_as_uint(Hc) << 32) | (unsigned long long)((__float_as_uint(Pc) & ~3u) | tag), RLX_AGENT);
                }
                if (u + G < NUB) {
                    const int r0N = mix_tile_row0((u + G) >> 4); const bool prtN = ((u + G) >> 4) < 128; LAS float* XCN = XC3 + xbn * (33792 / 4); LAS bf16* AtN = At2 + abn * (17408 / 2);
            if (prtN) {
                const f32x4 cb0 = *(const LAS f32x4*)(CWL + q16 * 8), cb1 = *(const LAS f32x4*)(CWL + q16 * 8 + 4);
#pragma unroll
                for (int i = 0; i < 2; ++i) {
                    const int rl = (tid >> 4) + 32 * i, t = (r0N + rl) & 2047;
                    f32x4 x0 = cb0, x1 = cb1;
#pragma unroll
                    for (int k = 0; k < 4; ++k) { const float f = ((3 - k) <= t) ? 1.0f : 0.0f;
                        const f32x4 w0 = *(const LAS f32x4*)(CWL + (k + 1) * 128 + q16 * 8), w1 = *(const LAS f32x4*)(CWL + (k + 1) * 128 + q16 * 8 + 4);
                        BF8_TO_F32(pre[i][k], a0, a1); x0 += w0 * (a0 * f); x1 += w1 * (a1 * f); }
                    *(LAS f32x4*)(XCN + rl * 132 + q16 * 8) = x0; *(LAS f32x4*)(XCN + rl * 132 + q16 * 8 + 4) = x1;
                    v4u o; o.x = pk2(x0[0], x0[1]); o.y = pk2(x0[2], x0[3]); o.z = pk2(x1[0], x1[1]); o.w = pk2(x1[2], x1[3]);
                    *(LAS v4u*)(AtN + rl * 136 + q16 * 8) = o;
                }
            } else {
                const float* sconv = p.in[3] + (size_t)layer * 128 * 3 * LW;
#pragma unroll 1
                for (int i = 0; i < 2; ++i) {
                    const int rl = (tid >> 4) + 32 * i, r = r0N + rl, c = c0 + q16 * 8, t = (r - NP) & 7, bs = (r - NP) >> 3;
                    f32x4 x0 = *(const LAS f32x4*)(CWL + q16 * 8), x1 = *(const LAS f32x4*)(CWL + q16 * 8 + 4);
#pragma unroll
                    for (int k = 0; k < 4; ++k) { const int jb = 3 - k;
                        const f32x4 w0 = *(const LAS f32x4*)(CWL + (k + 1) * 128 + q16 * 8), w1 = *(const LAS f32x4*)(CWL + (k + 1) * 128 + q16 * 8 + 4);
                        if (jb <= t) { const v4u vw = *(const v4u*)(PROJ + (size_t)(r - jb) * NC + C_UB + c); BF8_TO_F32(vw, a0, a1); x0 += w0 * a0; x1 += w1 * a1; }
                        else { const float* sp = sconv + ((size_t)bs * 3 + (3 + t - jb)) * LW + c; x0 += w0 * *(const f32x4*)sp; x1 += w1 * *(const f32x4*)(sp + 4); }
                    }
                    *(LAS f32x4*)(XCN + rl * 132 + q16 * 8) = x0; *(LAS f32x4*)(XCN + rl * 132 + q16 * 8 + 4) = x1;
                    v4u o; o.x = pk2(x0[0], x0[1]); o.y = pk2(x0[2], x0[3]); o.z = pk2(x1[0], x1[1]); o.w = pk2(x1[2], x1[3]);
                    *(LAS v4u*)(AtN + rl * 136 + q16 * 8) = o;
                }
            }
                    if (u + 2 * G < NUB) MIX_PREFETCH_B(u + 2 * G);
                }
                if (prt) {
                const int b_ = r0 >> 11, c_ = (r0 & 2047) >> 6;
                const unsigned tag = (unsigned)layer + 1u;
                unsigned long long* T1 = (unsigned long long*)(ws + WS_TOT2) + (size_t)(b_ * 32) * LW + ch;
                unsigned* PF = (unsigned*)(ws + WS_PREF2) + (size_t)(b_ * 32) * LW + ch;
                float Hin = 0.f;
                if (c_ > 0) {
                    float Pacc = 1.f, Hacc = 0.f; bool done = false;
                    for (int base = 0; !done; base += 4) {
                        const int jc = c_ - 1 - base - fq;
                        unsigned long long w1 = 0ull; unsigned w2 = 0u, spins = 0u; int gstop = 4;
                        for (;;) {
                            bool v1 = true, v2 = true;
                            if (jc >= 0) { w1 = __hip_atomic_load(T1 + (size_t)jc * LW, RLX_AGENT); w2 = __hip_atomic_load(PF + (size_t)jc * LW, RLX_AGENT);
                                v1 = (((unsigned)w1) & 3u) == tag; v2 = (w2 & 3u) == tag; }
                            const unsigned long long m1 = __ballot(v1), m2 = __ballot(v2);
                            bool decided = true; gstop = 4;
#pragma unroll
                            for (int g = 3; g >= 0; --g) {
                                const unsigned s2 = (unsigned)(m2 >> (16 * g)) & 0xFFFFu, s1 = (unsigned)(m1 >> (16 * g)) & 0xFFFFu;
                                if (s2 == 0xFFFFu) { gstop = g; decided = true; } else if (s1 != 0xFFFFu) { gstop = 4; decided = false; }
                            }
                            if (decided || ++spins > (1u << 22)) break;
                        }
                        const float Pv = __uint_as_float(((unsigned)w1) & ~3u), Hv = __uint_as_float((unsigned)(w1 >> 32)), Fv = (jc >= 0) ? __uint_as_float(w2 & ~3u) : 0.f;
#pragma unroll
                        for (int g = 0; g < 4; ++g) {
                            const float Pg_ = __shfl(Pv, 16 * g + fr), Hg_ = __shfl(Hv, 16 * g + fr), Fg_ = __shfl(Fv, 16 * g + fr);
                            if (!done) { if (g == gstop) { Hin = Pacc * Fg_ + Hacc; done = true; } else if (g < gstop) { Hacc = Hacc + Pacc * Hg_; Pacc = Pacc * Pg_; } }
                        }
                        if (spins > (1u << 20)) done = true;
                    }
                }
                const float Hout = Pc * Hin + Hc;
                if (fq == 0) __hip_atomic_store(PF + (size_t)c_ * LW, (__float_as_uint(Hout) & ~3u) | tag, RLX_AGENT);
                if (c_ == 31 && fq == 0) out[O_HP + (size_t)(layer * 4 + b_) * LW + ch] = Hout;
#pragma unroll
                    for (int m = 0; m < 4; ++m)
#pragma unroll
                        for (int jj = 0; jj < 4; ++jj) hl[m][jj] = hl[m][jj] + pl[m][jj] * Hin;
                }
#pragma unroll
                for (int m = 0; m < 4; ++m)
#pragma unroll
                    for (int jj = 0; jj < 4; ++jj) XC[(m * 16 + fq * 4 + jj) * 132 + cw + fr] = hl[m][jj];
                __syncthreads();
            {
                const int row = yrow, c16 = yc16; const size_t r = (size_t)(r0 + row);
                const v4u g0 = sgc0, g1 = sgc1;
                const f32x4 h0 = *(const LAS f32x4*)(XC + row * 132 + c16), h1 = *(const LAS f32x4*)(XC + row * 132 + c16 + 4),
                            h2 = *(const LAS f32x4*)(XC + row * 132 + c16 + 8), h3 = *(const LAS f32x4*)(XC + row * 132 + c16 + 12);
                v4u o0, o1;
                o0.x = pk2(h0[0] * bflo(g0.x), h0[1] * bfhi(g0.x)); o0.y = pk2(h0[2] * bflo(g0.y), h0[3] * bfhi(g0.y)); o0.z = pk2(h1[0] * bflo(g0.z), h1[1] * bfhi(g0.z)); o0.w = pk2(h1[2] * bflo(g0.w), h1[3] * bfhi(g0.w));
                o1.x = pk2(h2[0] * bflo(g1.x), h2[1] * bfhi(g1.x)); o1.y = pk2(h2[2] * bflo(g1.y), h2[3] * bfhi(g1.y)); o1.z = pk2(h3[0] * bflo(g1.z), h3[1] * bfhi(g1.z)); o1.w = pk2(h3[2] * bflo(g1.w), h3[3] * bfhi(g1.w));
                bf16* yp = (bf16*)(ws + WS_YA) + r * KCAT + PW + c0 + c16;
                *(v4u*)yp = o0; *(v4u*)(yp + 8) = o1;
            }
                xb = xbn; ab = abn;
            }
        }
#undef MIX_PREFETCH_B
    }
    __syncthreads();
    {
        LAS float* SL = (LAS float*)lds;
        LAS bf16* At = (LAS bf16*)(lds + 92 * 264 * 4);
        const int q = tid & 31, i0 = tid >> 5;
        int g_cur = -1;
        bf16x8 b[2][8]; f32x4 ps[2];
        v4u vw[3]; v2u sgv[2][2];
#define MIX_PREFETCH_A(uu) do { const int g__ = (uu) & 3, r0__ = ((uu) >> 2) * 32; \
        _Pragma("unroll") for (int n__ = 0; n__ < 2; ++n__) _Pragma("unroll") for (int m__ = 0; m__ < 2; ++m__) \
            sgv[m__][n__] = *(const v2u*)(PROJ + (size_t)(r0__ + m__ * 16 + fr) * NC + C_GA + g__ * 256 + wid * 32 + n__ * 16 + fq * 4); \
        if (r0__ < NP) { const int t0__ = r0__ & 2047; _Pragma("unroll") for (int k__ = 0; k__ < 3; ++k__) { const int i__ = i0 + 16 * k__; const bool ok__ = (i__ < 47) && (t0__ - 15 + i__ >= 0); \
            vw[k__] = *(const v4u*)(PROJ + (size_t)(ok__ ? r0__ - 15 + i__ : r0__) * NC + C_UA + g__ * 256 + q * 8); } } } while (0)
        int ua = (int)blockIdx.x;
        if (ua < NUA) MIX_PREFETCH_A(ua);
        for (; ua < NUA; ua += G) {
            const int tt = ua >> 2, g = ua & 3, r0 = tt * 32, w = 2 << g;
            const bool prt = r0 < NP;
            const int col = g * 256 + q * 8;
            __syncthreads();
            if (g != g_cur) { g_cur = g;
                const bf16* WT = (const bf16*)(ws + WS_POOLW) + (size_t)(layer * 4 + g) * 65536 + (size_t)(wid * 32 + fr) * 256 + fq * 8;
#pragma unroll
                for (int n = 0; n < 2; ++n)
#pragma unroll
                    for (int ks = 0; ks < 8; ++ks) b[n][ks] = *(const bf16x8*)(WT + (size_t)n * 16 * 256 + ks * 32);
#pragma unroll
                for (int n = 0; n < 2; ++n) ps[n] = *(const f32x4*)(p.in[8] + layer * PW + g * 256 + wid * 32 + n * 16 + fq * 4); }
            if (prt) {
                const int t0 = r0 & 2047;
#pragma unroll
                for (int k = 0; k < 3; ++k) { const int i = i0 + 16 * k; const float f = ((i < 47) && (t0 - 15 + i >= 0)) ? 1.0f : 0.0f; BF8_TO_F32(vw[k], a0, a1);
                    if (i < 47) { *(LAS f32x4*)(SL + i * 264 + q * 8) = a0 * f; *(LAS f32x4*)(SL + i * 264 + q * 8 + 4) = a1 * f; } }
            } else {
                const float* spool = p.in[2] + (size_t)layer * 128 * 15 * PW; const int bs0 = (r0 - NP) >> 3;
#pragma unroll 2
                for (int i = tid >> 5; i < 92; i += 16) { const int sq = i / 23, ii = i - sq * 23; f32x4 a0, a1;
                    if (ii < 15) { const float* sp = spool + ((size_t)(bs0 + sq) * 15 + ii) * PW + col; a0 = *(const f32x4*)sp; a1 = *(const f32x4*)(sp + 4); }
                    else { const v4u vv = *(const v4u*)(PROJ + (size_t)(NP + (bs0 + sq) * 8 + (ii - 15)) * NC + C_UA + col); BF8_TO_F32(vv, c0_, c1_); a0 = c0_; a1 = c1_; }
                    *(LAS f32x4*)(SL + i * 264 + q * 8) = a0; *(LAS f32x4*)(SL + i * 264 + q * 8 + 4) = a1; }
            }
            __syncthreads();
            v2u sgc[2][2];
#pragma unroll
            for (int m = 0; m < 2; ++m)
#pragma unroll
                for (int n = 0; n < 2; ++n) sgc[m][n] = sgv[m][n];
            if (ua + G < NUA) MIX_PREFETCH_A(ua + G);
#pragma unroll
            for (int i = 0; i < 2; ++i) {
                const int rl = (tid >> 5) + 16 * i, bi = prt ? rl + 15 : (rl >> 3) * 23 + 15 + (rl & 7), t = (r0 + rl) & 2047;
                const LAS float* sp = SL + bi * 264 + q * 8;
                const f32x4 u0 = *(const LAS f32x4*)sp, u1 = *(const LAS f32x4*)(sp + 4);
                f32x4 s0 = u0, s1 = u1;
#pragma unroll 4
                for (int j = 1; j < w; ++j) { s0 += *(const LAS f32x4*)(sp - j * 264); s1 += *(const LAS f32x4*)(sp - j * 264 + 4); }
                const int cnt = (prt && t + 1 < w) ? t + 1 : w; const float inv = 1.0f / (float)cnt;
                const f32x4 d0 = s0 * inv - u0, d1 = s1 * inv - u1;
                v4u o; o.x = pk2(d0[0], d0[1]); o.y = pk2(d0[2], d0[3]); o.z = pk2(d1[0], d1[1]); o.w = pk2(d1[2], d1[3]);
                *(LAS v4u*)(At + rl * 264 + q * 8) = o;
            }
            __syncthreads();
            f32x4 acc[2][2];
#pragma unroll
            for (int m = 0; m < 2; ++m)
#pragma unroll
                for (int n = 0; n < 2; ++n) acc[m][n] = (f32x4){0.f, 0.f, 0.f, 0.f};
#pragma unroll
            for (int ks = 0; ks < 8; ++ks) {
                bf16x8 a[2];
#pragma unroll
                for (int m = 0; m < 2; ++m) a[m] = *(const LAS bf16x8*)(At + (m * 16 + fr) * 264 + ks * 32 + fq * 8);
#pragma unroll
                for (int m = 0; m < 2; ++m)
#pragma unroll
                    for (int n = 0; n < 2; ++n) acc[m][n] = __builtin_amdgcn_mfma_f32_16x16x32_bf16(b[n][ks], a[m], acc[m][n], 0, 0, 0);
            }
            bf16* YA = (bf16*)(ws + WS_YA);
#pragma unroll
            for (int m = 0; m < 2; ++m)
#pragma unroll
                for (int n = 0; n < 2; ++n) { const int r = r0 + m * 16 + fr, ch = g * 256 + wid * 32 + n * 16 + fq * 4; const v2u sg = sgc[m][n];
                    const f32x4 y = acc[m][n] * ps[n] * (f32x4){bflo(sg.x), bfhi(sg.x), bflo(sg.y), bfhi(sg.y)};
                    v2u o; o.x = pk2(y[0], y[1]); o.y = pk2(y[2], y[3]); *(v2u*)(YA + (size_t)r * KCAT + ch) = o; }
        }
#undef MIX_PREFETCH_A
    }
    if (!(G == 256 && layer == 1)) state_copies(p, layer, (int)blockIdx.x, G);
}

__device__ __forceinline__ void ln_phase(const Params& p, const int layer, const int row_lo, const int row_hi, const int wg_id, const int n_wg) {
    int tid_ = threadIdx.x; asm volatile("" : "+v"(tid_)); const int tid = tid_, lane = tid & 63, wave = tid >> 6;
    const int gw = wg_id * NWAVES + wave, NGW = n_wg * NWAVES;
    unsigned char* ws = p.ws; asm volatile("" : "+s"(ws)); float* Z = p.out; bf16* XB = (bf16*)(ws + WS_XB);
    const float* g = p.in[19] + layer * DM; const float* bb = p.in[20] + layer * DM;
    const bf16* OB = (const bf16*)(ws + WS_TMP);
    for (int m0 = row_lo + gw; m0 < row_hi; m0 += 2 * NGW) {
        const int m1r = m0 + NGW; const bool ok1 = m1r < row_hi; const int m1 = ok1 ? m1r : m0;
        const v2u* ob0 = (const v2u*)(OB + (size_t)m0 * DM) + lane; const v2u* ob1 = (const v2u*)(OB + (size_t)m1 * DM) + lane;
        f32x4 v0[8], v1[8]; v2u w0[8], w1[8]; float s0 = 0.f, s1 = 0.f;
        if (layer == 0) {
            const f32x4* xr0 = (const f32x4*)((m0 < NP) ? p.in[0] + (size_t)m0 * DM : p.in[1] + (size_t)(m0 - NP) * DM) + lane;
            const f32x4* xr1 = (const f32x4*)((m1 < NP) ? p.in[0] + (size_t)m1 * DM : p.in[1] + (size_t)(m1 - NP) * DM) + lane;
#pragma unroll
            for (int j = 0; j < 8; ++j) { v0[j] = xr0[64 * j]; v1[j] = xr1[64 * j]; w0[j] = ob0[64 * j]; w1[j] = ob1[64 * j]; }
        } else {
            const v2u* xb0 = (const v2u*)(XB + (size_t)m0 * DM) + lane; const v2u* xb1 = (const v2u*)(XB + (size_t)m1 * DM) + lane;
            v2u a0[8], a1[8];
#pragma unroll
            for (int j = 0; j < 8; ++j) { a0[j] = xb0[64 * j]; a1[j] = xb1[64 * j]; w0[j] = ob0[64 * j]; w1[j] = ob1[64 * j]; }
#pragma unroll
            for (int j = 0; j < 8; ++j) { v0[j] = (f32x4){bflo(a0[j].x), bfhi(a0[j].x), bflo(a0[j].y), bfhi(a0[j].y)}; v1[j] = (f32x4){bflo(a1[j].x), bfhi(a1[j].x), bflo(a1[j].y), bfhi(a1[j].y)}; }
        }
#pragma unroll
        for (int j = 0; j < 8; ++j) { v0[j] = v0[j] * DN_ALPHA + (f32x4){bflo(w0[j].x), bfhi(w0[j].x), bflo(w0[j].y), bfhi(w0[j].y)};
            v1[j] = v1[j] * DN_ALPHA + (f32x4){bflo(w1[j].x), bfhi(w1[j].x), bflo(w1[j].y), bfhi(w1[j].y)};
            s0 += (v0[j].x + v0[j].y) + (v0[j].z + v0[j].w); s1 += (v1[j].x + v1[j].y) + (v1[j].z + v1[j].w); }
        const float mean0 = wave_sum(s0) * (1.f / DM), mean1 = wave_sum(s1) * (1.f / DM); float q0 = 0.f, q1 = 0.f;
#pragma unroll
        for (int j = 0; j < 8; ++j) { v0[j] = v0[j] - mean0; v1[j] = v1[j] - mean1;
            q0 += (v0[j].x * v0[j].x + v0[j].y * v0[j].y) + (v0[j].z * v0[j].z + v0[j].w * v0[j].w); q1 += (v1[j].x * v1[j].x + v1[j].y * v1[j].y) + (v1[j].z * v1[j].z + v1[j].w * v1[j].w); }
        const float rstd0 = 1.f / sqrtf(wave_sum(q0) * (1.f / DM) + LN_EPS), rstd1 = 1.f / sqrtf(wave_sum(q1) * (1.f / DM) + LN_EPS);
        f32x4* zr0 = (f32x4*)(Z + (size_t)m0 * DM) + lane; f32x4* zr1 = (f32x4*)(Z + (size_t)m1 * DM) + lane;
        unsigned long long* o80 = (unsigned long long*)(XB + (size_t)m0 * DM) + lane; unsigned long long* o81 = (unsigned long long*)(XB + (size_t)m1 * DM) + lane;
#pragma unroll
        for (int j = 0; j < 8; ++j) { const f32x4 gv = *((const f32x4*)g + lane + 64 * j), bv = *((const f32x4*)bb + lane + 64 * j);
            const f32x4 y0 = v0[j] * rstd0 * gv + bv, y1 = v1[j] * rstd1 * gv + bv;
            if (layer == 0) { o80[64 * j] = (unsigned long long)pk2(y0.x, y0.y) | ((unsigned long long)pk2(y0.z, y0.w) << 32);
                if (ok1) o81[64 * j] = (unsigned long long)pk2(y1.x, y1.y) | ((unsigned long long)pk2(y1.z, y1.w) << 32); }
            else { zr0[64 * j] = y0; if (ok1) zr1[64 * j] = y1; } }
    }
}

#define XB_TMO      128
#define XB_XCNT(j)  (256  + 64 * (j))
#define XB_XSUB(j)  (1280 + 64 * (j))
#define XB_XGEN(j)  (2304 + 64 * (j))
#define XB_TOP      3328
#define XB_TOPGEN   3392
#define XCD_BAR_WORDS 3456
#define XB_SPIN_CAP (1u << 18)

__device__ __forceinline__ unsigned xb_ld(unsigned* p)              { return __hip_atomic_load(p, __ATOMIC_RELAXED, __HIP_MEMORY_SCOPE_AGENT); }
__device__ __forceinline__ unsigned xb_add(unsigned* p, unsigned v) { return __hip_atomic_fetch_add(p, v, __ATOMIC_RELAXED, __HIP_MEMORY_SCOPE_AGENT); }
__device__ __forceinline__ unsigned xb_xcc_id() { return (unsigned)__builtin_amdgcn_s_getreg((3 << 11) | 20) & 0xFu; }
#define XB_SPIN(cond, bar) do { unsigned _sp = 0; while (cond) { __builtin_amdgcn_s_sleep(1); \
    if ((++_sp & 255u) == 0u) { if (xb_ld(&(bar)[XB_TMO])) break; if (_sp > XB_SPIN_CAP) { atomicAdd(&(bar)[XB_TMO], 1u); break; } } } } while (0)

struct XcdBarrier {
    unsigned* bar; unsigned x;
    volatile LAS unsigned* st;
};

__device__ __forceinline__ XcdBarrier xcd_barrier_post(unsigned* bar, volatile LAS unsigned* st) {
    XcdBarrier b; b.bar = bar; b.x = xb_xcc_id(); b.st = st;
    if (threadIdx.x == 0) (void)xb_add(&bar[XB_XCNT(b.x)], 1u);
    return b;
}
__device__ __forceinline__ void xcd_barrier_complete(unsigned* bar, unsigned x, unsigned& nloc, unsigned& nx) {
    const unsigned G = gridDim.x * gridDim.y * gridDim.z;
    unsigned sum, cnt, mine, sp = 0u;
    for (;;) {
        sum = 0u; cnt = 0u; mine = 0u;
#pragma unroll
        for (unsigned j = 0; j < 16; ++j) { const unsigned c = xb_ld(&bar[XB_XCNT(j)]); sum += c; cnt += (c > 0u) ? 1u : 0u; mine = (j == x) ? c : mine; }
        if (sum == G) break;
        __builtin_amdgcn_s_sleep(1);
        if ((++sp & 255u) == 0u) { if (xb_ld(&bar[XB_TMO])) break; if (sp > XB_SPIN_CAP) { atomicAdd(&bar[XB_TMO], 1u); break; } }
    }
    nloc = mine > 0u ? mine : 1u; nx = cnt > 0u ? cnt : 1u;
}

__device__ __forceinline__ void xcd_barrier(const XcdBarrier& b) {
    asm volatile("s_waitcnt vmcnt(0)" ::: "memory");
    __syncthreads();
    if (threadIdx.x == 0) {
        unsigned* bar = b.bar;
        __builtin_amdgcn_s_waitcnt(0);
        unsigned nloc = b.st[0], nx = b.st[1];
        if (nloc == 0u) { xcd_barrier_complete(bar, b.x, nloc, nx); b.st[0] = nloc; b.st[1] = nx; }
        const unsigned old = xb_add(&bar[XB_XSUB(b.x)], 1u);
        const unsigned gen = old / nloc;
        if (old + 1u == (gen + 1u) * nloc) {
            __builtin_amdgcn_fence(__ATOMIC_RELEASE, "agent");
            asm volatile("s_waitcnt vmcnt(0)" ::: "memory");
            const unsigned og = xb_add(&bar[XB_TOP], 1u);
            const unsigned tg = og / nx;
            if (og + 1u == (tg + 1u) * nx) xb_add(&bar[XB_TOPGEN], 1u);
            else XB_SPIN(xb_ld(&bar[XB_TOPGEN]) == tg, bar);
            __builtin_amdgcn_fence(__ATOMIC_ACQUIRE, "agent");
            xb_add(&bar[XB_XGEN(b.x)], 1u);
            asm volatile("s_waitcnt vmcnt(0)" ::: "memory");
        } else {
            XB_SPIN(xb_ld(&bar[XB_XGEN(b.x)]) == gen, bar);
            __builtin_amdgcn_fence(__ATOMIC_ACQUIRE, "agent");
            asm volatile("s_waitcnt vmcnt(0)" ::: "memory");
        }
    }
    __syncthreads();
}

constexpr int W1_EARLY = 1536;
constexpr int LN_EARLY_SPLIT = 24 * 256;
constexpr int LN_EARLY_ROWS = 28 * 256;
struct ListOrder {
    int start, stride, count;
    __device__ __forceinline__ bool next(int i, pg8::Unit& u) const { if (i >= count) return false; const int L = start + i * stride; u.pm = L >> 3; u.pn = L & 7; return true; }
    __device__ __forceinline__ void a_ready(const pg8::Unit&) const {}
    __device__ __forceinline__ void done(const pg8::Unit&) const {}
};
__device__ __forceinline__ int wave_id_l() { int t = threadIdx.x; asm volatile("" : "+v"(t)); return t >> 6; }
__global__ void __launch_bounds__(NTHR, 2) hybrid_fwd(Params p) {
    extern __shared__ __attribute__((aligned(16))) unsigned char lds_raw[];
    LAS unsigned char* lds = (LAS unsigned char*)lds_raw;
    cg::grid_group grid = cg::this_grid();
    volatile LAS unsigned* MISC = (volatile LAS unsigned*)(lds + LDS_MISC);
    if (threadIdx.x < 64) MISC[threadIdx.x] = 0u;
    __syncthreads();
    XcdBarrier bar = xcd_barrier_post((unsigned*)(p.ws + WS_CTL), MISC);
    if (p.ph_lo < 0) grid.sync();
    const int lo = p.ph_lo, hi = p.ph_hi;
#define IN(k) (lo <= (k) && (k) < hi)
#define SEAM(k) do { if (IN(k) && IN((k) + 1)) xcd_barrier(bar); } while (0)
#ifdef EXTRA_SYNCS
    for (int rep = 0; rep < EXTRA_SYNCS; ++rep) xcd_barrier(bar);
#endif
    if (IN(0)) { for (int rep = 0; rep <= DUP_P0; ++rep) p0_prologue(lds, p); }
    SEAM(0);
#pragma unroll 1
    for (int l = 0; l < 2; ++l) {
        const int pb = 1 + 6 * l;
        unsigned char* ws = p.ws; asm volatile("" : "+s"(ws));
        bf16* PROJ = (bf16*)(ws + WS_PROJ);
        if (IN(pb + 0)) {
            pg8::Gemm g{(const bf16*)(ws + WS_XB), (const bf16*)(ws + WS_WIN + l * SZ_WIN), MT, NC, DM, DM};
            pg8::StaticOrder S; S.init(MT, NC, (int)gridDim.x, (int)blockIdx.x);
            pg8::EpiProj E{PROJ, NC, p.in[6] + (size_t)l * 2 * DM};
            for (int rep = 0; rep <= DUP_G1; ++rep) pg8::gemm_phase<pg8::EpiProj, pg8::StaticOrder, true, true>(lds, g, S, E);
            if (gridDim.x == 256 && blockIdx.x >= 160) {
                const int gw = ((int)blockIdx.x - 160) * NWAVES + wave_id_l(), NGW = ((int)gridDim.x - 160) * NWAVES;
                convert_range(lds, p, IT_PA + l * I_PA, IT_PA + (l + 1) * I_PA, gw, NGW); convert_range(lds, p, IT_PB + l * I_PB, IT_PB + (l + 1) * I_PB, gw, NGW);
                convert_range(lds, p, IT_OUT + l * I_OUT, IT_OUT + (l + 1) * I_OUT, gw, NGW);
                if (l == 0) convert_range(lds, p, IT_IN + I_IN, IT_IN + I_IN + W1_EARLY, gw, NGW); }
            else if (l == 1 && gridDim.x != 256 && false) {}
        }
        SEAM(pb + 0);
        if (IN(pb + 1)) { for (int rep = 0; rep <= DUP_MIX; ++rep) mix_phase(lds, p, l); }
        SEAM(pb + 1);
        if (IN(pb + 3)) {
            const int c = (int)blockIdx.x, G = (int)gridDim.x; const bool g256 = (G == 256);
            constexpr int NU = (MT / 256) * (DM / 256);
#pragma unroll 1
            for (int step = 0; step < 3; ++step) {
                ListOrder SM{0, 1, 0}, SO{0, 1, 0};
                const bool split = g256;
                int kh = -1;
                if (split) {
                    if (step == 0) SM = ListOrder{c, 256, 1};
                    else if (step == 1) { if (c < 64) { SM = ListOrder{256 + (c >> 1), 256, 1}; kh = c & 1; } else SO = ListOrder{c - 64, 256, 1}; }
                    else { if (c >= 32 && c < 128) SO = ListOrder{192 + (c - 32), 256, 1}; }
                } else if (g256) {
                    if (step == 0) SM = ListOrder{c, 256, 1};
                    else if (step == 1) { if (c < 32) SM = ListOrder{256 + c, 256, 1}; else SO = ListOrder{c - 32, 256, 1}; }
                    else { if (c >= 32 && c < 96) SO = ListOrder{224 + (c - 32), 256, 1}; }
                } else {
                    if (step == 0) SM = ListOrder{c, G, c < NU ? (NU - 1 - c) / G + 1 : 0};
                    else if (step == 2) SO = ListOrder{c, G, c < NU ? (NU - 1 - c) / G + 1 : 0};
                }
                if (SM.count) {
                    const int ko = (kh == 1) ? KCAT / 2 : 0;
                    pg8::Gemm g{(const bf16*)(ws + WS_YA) + ko, (const bf16*)(ws + WS_WCAT + l * SZ_WCAT) + ko, MT, DM, (kh >= 0) ? KCAT / 2 : KCAT, KCAT};
                    pg8::EpiMerge E{(kh >= 0) ? (bf16*)(ws + WS_HL) + (size_t)kh * MT * DM : (bf16*)(ws + WS_PP), PROJ, NC, (kh == 1) ? -1 : PW / 64, (kh >= 0) ? 1 : 0};
                    pg8::gemm_phase<pg8::EpiMerge, ListOrder, true, true>(lds, g, SM, E);
                }
                if (SO.count) {
                    pg8::Gemm g{(const bf16*)(ws + WS_PP), (const bf16*)(ws + WS_WOUT + l * SZ_WOUT), MT, DM, DM, DM};
                    pg8::EpiOutB E{(bf16*)(ws + WS_TMP)};
                    pg8::gemm_phase<pg8::EpiOutB, ListOrder, true, true>(lds, g, SO, E);
                }
                if (l == 0 && split && step == 2 && (c < 32 || c >= 128)) {
                    const int gw = (c < 32 ? c : c - 96) * NWAVES + wave_id_l(), NGW = (G - 96) * NWAVES;
                    convert_range(lds, p, IT_IN + I_IN + W1_EARLY, IT_IN + 2 * I_IN, gw, NGW); }
                if (g256 && !split && step == 2 && (c < 32 || c >= 96)) ln_phase(p, l, 0, LN_EARLY_ROWS, c < 32 ? c : c - 64, G - 64);
                if (split && step == 2 && (c < 32 || c >= 128)) ln_phase(p, l, 0, LN_EARLY_SPLIT, c < 32 ? c : c - 96, G - 96);
                if (split && l == 1 && step == 2 && (c < 32 || c >= 128)) state_copies(p, l, c < 32 ? c : c - 96, G - 96);
                if (step < 2) xcd_barrier(bar);
                if (split && step == 1) {
                    const bf16* P0 = (const bf16*)(ws + WS_HL); const bf16* P1 = P0 + (size_t)MT * DM; bf16* MG = (bf16*)(ws + WS_PP);
                    for (int it = c * NTHR + (int)threadIdx.x; it < 1024 * 256; it += G * NTHR) { const size_t r = (size_t)(NP + (it >> 8)); const int c8 = (it & 255) * 8;
                        const v4u a = *(const v4u*)(P0 + r * DM + c8), b = *(const v4u*)(P1 + r * DM + c8), gq = *(const v4u*)(PROJ + r * NC + C_MB + c8);
                        v4u o;
                        o.x = pk2(fmaxf(bflo(gq.x), 1e-30f) * (bflo(a.x) + bflo(b.x)), fmaxf(bfhi(gq.x), 1e-30f) * (bfhi(a.x) + bfhi(b.x)));
                        o.y = pk2(fmaxf(bflo(gq.y), 1e-30f) * (bflo(a.y) + bflo(b.y)), fmaxf(bfhi(gq.y), 1e-30f) * (bfhi(a.y) + bfhi(b.y)));
                        o.z = pk2(fmaxf(bflo(gq.z), 1e-30f) * (bflo(a.z) + bflo(b.z)), fmaxf(bfhi(gq.z), 1e-30f) * (bfhi(a.z) + bfhi(b.z)));
                        o.w = pk2(fmaxf(bflo(gq.w), 1e-30f) * (bflo(a.w) + bflo(b.w)), fmaxf(bfhi(gq.w), 1e-30f) * (bfhi(a.w) + bfhi(b.w)));
                        *(v4u*)(MG + r * DM + c8) = o; }
                    xcd_barrier(bar);
                }
            }
        }
        SEAM(pb + 3);
        if (IN(pb + 5)) ln_phase(p, l, (gridDim.x == 256) ? LN_EARLY_SPLIT : 0, MT, (int)blockIdx.x, (int)gridDim.x);
        if (l == 0) SEAM(pb + 5);
    }
#undef IN
#undef SEAM
}

#ifndef MK_N_LAUNCHES
#define MK_N_LAUNCHES 1
#endif
extern "C" void kernel_launch(void* const* d_in, const int* in_sizes, int n_in, void* d_out, int out_size, void* d_ws, size_t ws_size, hipStream_t stream) {
    static int grid = 0;
    if (grid == 0) {
        if (n_in != 21 || (size_t)out_size != O_END || ws_size < WS_END) { fprintf(stderr, "kernel_launch: unexpected shapes: n_in %d out %d ws %zu (need %zu)\n", n_in, out_size, ws_size, (size_t)WS_END); grid = -1; return; }
        int dev = 0, cus = 0, per_cu = 0;
        if (hipGetDevice(&dev) != hipSuccess || hipDeviceGetAttribute(&cus, hipDeviceAttributeMultiprocessorCount, dev) != hipSuccess) { grid = -1; return; }
        if (hipFuncSetAttribute((const void*)hybrid_fwd, hipFuncAttributeMaxDynamicSharedMemorySize, LDS_BYTES) != hipSuccess) { fprintf(stderr, "kernel_launch: hipFuncSetAttribute failed\n"); grid = -1; return; }
        if (hipOccupancyMaxActiveBlocksPerMultiprocessor(&per_cu, (const void*)hybrid_fwd, NTHR, LDS_BYTES) != hipSuccess || per_cu < 1) { fprintf(stderr, "kernel_launch: occupancy query says %d\n", per_cu); per_cu = 1; }
        (void)hipGetLastError();
        grid = cus - cus % 16;
    }
    if (grid < 0) return;
    Params p{};
    for (int i = 0; i < 21; ++i) p.in[i] = (const float*)d_in[i];
    p.out = (float*)d_out; p.ws = (unsigned char*)d_ws;
    constexpr int NPH = 13;
    if (hipMemsetAsync((char*)d_ws + WS_CTL, 0, CTL_BYTES, stream) != hipSuccess) { fprintf(stderr, "kernel_launch: memset failed\n"); return; }
    if (MK_N_LAUNCHES == 1) {
        p.ph_lo = 0; p.ph_hi = NPH;
        void* args[] = {&p};
        const hipError_t e = hipLaunchCooperativeKernel((const void*)hybrid_fwd, dim3(grid), dim3(NTHR), args, LDS_BYTES, stream);
        if (e != hipSuccess) fprintf(stderr, "kernel_launch: cooperative launch failed: %s (grid %d)\n", hipGetErrorString(e), grid);
    } else {
        for (int ph = 0; ph < NPH; ++ph) { p.ph_lo = ph; p.ph_hi = ph + 1; hipLaunchKernelGGL(hybrid_fwd, dim3(grid), dim3(NTHR), LDS_BYTES, stream, p); }
    }
}
```

```cpp
#include <hip/hip_runtime.h>
#include <hip/hip_cooperative_groups.h>
#include <cstdio>
#include <cstdint>
namespace cg = cooperative_groups;

namespace pg8 {
#define PG8_LAS __attribute__((address_space(3)))
typedef unsigned short bf16_t;
typedef short bf16x8 __attribute__((ext_vector_type(8)));
typedef float f32x4 __attribute__((ext_vector_type(4)));
typedef unsigned u32x4 __attribute__((ext_vector_type(4)));
constexpr int BM = 256, BK = 64, HALF = 128, HTB = HALF * BK * 2  , STAGE_BYTES = 8 * HTB, NXCD = 8, WGM = 8;

__host__ __device__ __forceinline__ int lds_byte(int r, int c) { const int st = (r >> 4) * 2 + (c >> 5), rr = r & 15, cc = c & 31, ob = rr * 64 + cc * 2; return st * 1024 + (ob ^ (((ob >> 9) & 1) << 5)); }
__host__ __device__ __forceinline__ void stage_rc(int b, int& R, int& C) { const int st = b / 1024, sb = b % 1024, swz = sb ^ (((sb >> 9) & 1) << 5); R = (st >> 1) * 16 + swz / 64; C = (st & 1) * 32 + (swz % 64) / 2; }
__host__ __device__ __forceinline__ int perm32(int rho) { const int n = rho >> 4, i = rho & 15; return 8 * (i >> 2) + 4 * n + (i & 3); }

struct Unit { int pm, pn; };
struct Gemm { const bf16_t* A; const bf16_t* Bt; int M, N, K, ld; };

struct StaticOrder {
    int nM, nN, nwg, G, c;
    __host__ __device__ void init(int M, int N, int G_, int c_) { nM = M / BM; nN = N / BM; nwg = nM * nN; G = G_; c = c_; }
    __host__ __device__ bool next(int i, Unit& u) const {
        const long L = (long)i * G + c; if (L >= nwg) return false;
        int wgid = (int)L; { const int q = nwg / NXCD, r = nwg % NXCD, xcd = wgid % NXCD, off = wgid / NXCD; wgid = (xcd < r ? xcd * (q + 1) : r * (q + 1) + (xcd - r) * q) + off; }
        const int nig = WGM * nN, gid = wgid / nig, fm = gid * WGM, gsz = (nM - fm) < WGM ? (nM - fm) : WGM;
        u.pm = fm + ((wgid % nig) % gsz); u.pn = (wgid % nig) / gsz; return true;
    }
    __device__ __forceinline__ void a_ready(const Unit&) const {}
    __device__ __forceinline__ void done(const Unit&) const {}
};
__device__ __forceinline__ unsigned cvt_pk_bf16(float lo, float hi) { unsigned r; asm volatile("v_cvt_pk_bf16_f32 %0, %1, %2" : "=v"(r) : "v"(lo), "v"(hi)); return r; }
typedef unsigned u32x2 __attribute__((ext_vector_type(2)));
__device__ __forceinline__ float fast_sigmoid(float v) { return __builtin_amdgcn_rcpf(1.0f + __expf(-v)); }
struct EpiProj {
    static constexpr bool PERM = true, AFTER_DRAIN = false, HOOK = false;
    bf16_t* O; int ldc; const float* bmerge;
    __device__ __forceinline__ void operator()(const f32x4 (&acc)[2][2][4][2], const Unit& u, int wr, int wc, int fr, int fq) const {
        const int row0 = u.pm * BM + wr * 64 + fr; const int col0 = u.pn * BM + wc * 32 + 8 * fq;
        const int mode = (u.pn >= 24) ? 2 : (((u.pn >= 4 && u.pn < 8) || (u.pn >= 16)) ? 1 : 0);
        f32x4 bv[2][2];
#pragma unroll
        for (int bj = 0; bj < 2; ++bj)
#pragma unroll
            for (int n = 0; n < 2; ++n) bv[bj][n] = (mode == 2) ? *(const f32x4*)(bmerge + (col0 - 6144) + bj * HALF + 4 * n) : (f32x4){0.f, 0.f, 0.f, 0.f};
#pragma unroll
        for (int ai = 0; ai < 2; ++ai)
#pragma unroll
            for (int m = 0; m < 4; ++m) { bf16_t* rowp = O + (size_t)(row0 + ai * HALF + m * 16) * ldc + col0;
#pragma unroll
                for (int bj = 0; bj < 2; ++bj) { f32x4 v0 = acc[ai][bj][m][0] + bv[bj][0], v1 = acc[ai][bj][m][1] + bv[bj][1];
                    if (mode == 1) {
#pragma unroll
                        for (int j = 0; j < 4; ++j) { v0[j] = v0[j] * fast_sigmoid(v0[j]); v1[j] = v1[j] * fast_sigmoid(v1[j]); } }
                    else if (mode == 2) {
#pragma unroll
                        for (int j = 0; j < 4; ++j) { v0[j] = fast_sigmoid(v0[j]); v1[j] = fast_sigmoid(v1[j]); } }
                    u32x4 w; w.x = cvt_pk_bf16(v0[0], v0[1]); w.y = cvt_pk_bf16(v0[2], v0[3]); w.z = cvt_pk_bf16(v1[0], v1[1]); w.w = cvt_pk_bf16(v1[2], v1[3]);
                    *(u32x4*)(rowp + bj * HALF) = w; } }
    }
};
__device__ __forceinline__ void unpack_bf16x8(const u32x4 w, f32x4& lo, f32x4& hi) {
    lo[0] = __uint_as_float(w.x << 16); lo[1] = __uint_as_float(w.x & 0xffff0000u); lo[2] = __uint_as_float(w.y << 16); lo[3] = __uint_as_float(w.y & 0xffff0000u);
    hi[0] = __uint_as_float(w.z << 16); hi[1] = __uint_as_float(w.z & 0xffff0000u); hi[2] = __uint_as_float(w.w << 16); hi[3] = __uint_as_float(w.w & 0xffff0000u);
}
struct EpiMergeA {
    static constexpr bool PERM = true, AFTER_DRAIN = false, HOOK = false;
    float* T; const bf16_t* G; int ldg; int gcol0;
    __device__ __forceinline__ void operator()(const f32x4 (&acc)[2][2][4][2], const Unit& u, int wr, int wc, int fr, int fq) const {
        const int row0 = u.pm * BM + wr * 64 + fr; const int col0 = u.pn * BM + wc * 32 + 8 * fq;
#pragma unroll
        for (int ai = 0; ai < 2; ++ai)
#pragma unroll
            for (int m = 0; m < 4; ++m) { const size_t row = (size_t)(row0 + ai * HALF + m * 16);
#pragma unroll
                for (int bj = 0; bj < 2; ++bj) { const u32x4 gw = *(const u32x4*)(G + row * ldg + gcol0 + col0 + bj * HALF); f32x4 g0, g1; unpack_bf16x8(gw, g0, g1);
                    float* tp = T + row * 2048 + col0 + bj * HALF;
                    *(f32x4*)tp = acc[ai][bj][m][0] * g0; *(f32x4*)(tp + 4) = acc[ai][bj][m][1] * g1; }
                asm volatile("" ::: "memory"); }
    }
};
struct EpiMergeB {
    static constexpr bool PERM = true, AFTER_DRAIN = false, HOOK = false;
    const float* T; bf16_t* O; const bf16_t* G; int ldg; int gcol0;
    __device__ __forceinline__ void operator()(const f32x4 (&acc)[2][2][4][2], const Unit& u, int wr, int wc, int fr, int fq) const {
        const int row0 = u.pm * BM + wr * 64 + fr; const int col0 = u.pn * BM + wc * 32 + 8 * fq;
#pragma unroll
        for (int ai = 0; ai < 2; ++ai)
#pragma unroll
            for (int m = 0; m < 4; ++m) { const size_t row = (size_t)(row0 + ai * HALF + m * 16);
#pragma unroll
                for (int bj = 0; bj < 2; ++bj) { const u32x4 gw = *(const u32x4*)(G + row * ldg + gcol0 + col0 + bj * HALF); f32x4 g0, g1; unpack_bf16x8(gw, g0, g1);
                    const float* tp = T + row * 2048 + col0 + bj * HALF;
                    const f32x4 v0 = *(const f32x4*)tp + acc[ai][bj][m][0] * g0, v1 = *(const f32x4*)(tp + 4) + acc[ai][bj][m][1] * g1;
                    u32x4 w; w.x = cvt_pk_bf16(v0[0], v0[1]); w.y = cvt_pk_bf16(v0[2], v0[3]); w.z = cvt_pk_bf16(v1[0], v1[1]); w.w = cvt_pk_bf16(v1[2], v1[3]);
                    *(u32x4*)(O + row * 2048 + col0 + bj * HALF) = w; }
                asm volatile("" ::: "memory"); }
    }
};
struct EpiOut {
    static constexpr bool PERM = false, AFTER_DRAIN = false, HOOK = false;
    const float* xp; const float* xs; float* Z; float alpha;
    __device__ __forceinline__ void operator()(const f32x4 (&acc)[2][2][4][2], const Unit& u, int wr, int wc, int fr, int fq) const {
        const int row0 = u.pm * BM + wr * 64 + fr, col0 = u.pn * BM + wc * 32 + 4 * fq;
        const float* xb = (u.pm < 32) ? xp : (xs - (size_t)8192 * 2048);
#pragma unroll
        for (int ai = 0; ai < 2; ++ai)
#pragma unroll
            for (int m = 0; m < 4; ++m) { const size_t off = (size_t)(row0 + ai * HALF + m * 16) * 2048 + col0;
#pragma unroll
                for (int bj = 0; bj < 2; ++bj)
#pragma unroll
                    for (int n = 0; n < 2; ++n) { const f32x4 xv = *(const f32x4*)(xb + off + bj * HALF + n * 16);
                        *(f32x4*)(Z + off + bj * HALF + n * 16) = xv * alpha + acc[ai][bj][m][n]; }
                asm volatile("" ::: "memory"); }
    }
};
struct EpiMerge {
    static constexpr bool PERM = true, AFTER_DRAIN = false, HOOK = true;
    bf16_t* O; const bf16_t* G; int ldg; int hook_t; int raw;
    __device__ __forceinline__ void hook(f32x4 (&acc)[2][2][4][2], const Unit& u, int wr, int wc, int fr, int fq) const {
        int row0 = u.pm * BM + wr * 64 + fr, col0 = u.pn * BM + wc * 32 + 8 * fq;
        asm volatile("" : "+v"(row0), "+v"(col0));
        u32x4 ga[2][2], gb[2][2];
#pragma unroll
        for (int bj = 0; bj < 2; ++bj) { const bf16_t* gp = G + (size_t)row0 * ldg + col0 + bj * HALF; ga[0][bj] = *(const u32x4*)(gp + 6144); gb[0][bj] = *(const u32x4*)(gp + 8192); }
#pragma unroll
        for (int g = 0; g < 8; ++g) { const int ai = g >> 2, m = g & 3, cb = g & 1, nb_ = cb ^ 1;
            if (g < 7) { const int an = (g + 1) >> 2, mn = (g + 1) & 3;
#pragma unroll
                for (int bj = 0; bj < 2; ++bj) { const bf16_t* gp = G + (size_t)(row0 + an * HALF + mn * 16) * ldg + col0 + bj * HALF; ga[nb_][bj] = *(const u32x4*)(gp + 6144); gb[nb_][bj] = *(const u32x4*)(gp + 8192); } }
#pragma unroll
            for (int bj = 0; bj < 2; ++bj) { f32x4 a0, a1, b0, b1; unpack_bf16x8(ga[cb][bj], a0, a1); unpack_bf16x8(gb[cb][bj], b0, b1);
#pragma unroll
                for (int j = 0; j < 4; ++j) { a0[j] = a0[j] * __builtin_amdgcn_rcpf(fmaxf(b0[j], 1e-30f)); a1[j] = a1[j] * __builtin_amdgcn_rcpf(fmaxf(b1[j], 1e-30f)); }
                acc[ai][bj][m][0] = acc[ai][bj][m][0] * a0; acc[ai][bj][m][1] = acc[ai][bj][m][1] * a1; }
            asm volatile("" ::: "memory"); }
    }
    __device__ __forceinline__ void operator()(const f32x4 (&acc)[2][2][4][2], const Unit& u, int wr, int wc, int fr, int fq) const {
        const int row0 = u.pm * BM + wr * 64 + fr; const int col0 = u.pn * BM + wc * 32 + 8 * fq;
        if (raw) {
#pragma unroll
            for (int ai = 0; ai < 2; ++ai)
#pragma unroll
                for (int m = 0; m < 4; ++m)
#pragma unroll
                    for (int bj = 0; bj < 2; ++bj) { const f32x4 v0 = acc[ai][bj][m][0], v1 = acc[ai][bj][m][1];
                        u32x4 w; w.x = cvt_pk_bf16(v0[0], v0[1]); w.y = cvt_pk_bf16(v0[2], v0[3]); w.z = cvt_pk_bf16(v1[0], v1[1]); w.w = cvt_pk_bf16(v1[2], v1[3]);
                        *(u32x4*)(O + (size_t)(row0 + ai * HALF + m * 16) * 2048 + col0 + bj * HALF) = w; }
            return;
        }
        u32x4 gb[2][2];
#pragma unroll
        for (int bj = 0; bj < 2; ++bj) gb[0][bj] = *(const u32x4*)(G + (size_t)row0 * ldg + 8192 + col0 + bj * HALF);
#pragma unroll
        for (int g = 0; g < 8; ++g) { const int ai = g >> 2, m = g & 3, cb = g & 1, nb_ = cb ^ 1; const size_t row = (size_t)(row0 + ai * HALF + m * 16);
            if (g < 7) { const int an = (g + 1) >> 2, mn = (g + 1) & 3;
#pragma unroll
                for (int bj = 0; bj < 2; ++bj) gb[nb_][bj] = *(const u32x4*)(G + (size_t)(row0 + an * HALF + mn * 16) * ldg + 8192 + col0 + bj * HALF); }
#pragma unroll
            for (int bj = 0; bj < 2; ++bj) { f32x4 b0, b1; unpack_bf16x8(gb[cb][bj], b0, b1);
#pragma unroll
                for (int j = 0; j < 4; ++j) { b0[j] = fmaxf(b0[j], 1e-30f); b1[j] = fmaxf(b1[j], 1e-30f); }
                const f32x4 v0 = acc[ai][bj][m][0] * b0, v1 = acc[ai][bj][m][1] * b1;
                u32x4 w; w.x = cvt_pk_bf16(v0[0], v0[1]); w.y = cvt_pk_bf16(v0[2], v0[3]); w.z = cvt_pk_bf16(v1[0], v1[1]); w.w = cvt_pk_bf16(v1[2], v1[3]);
                *(u32x4*)(O + row * 2048 + col0 + bj * HALF) = w; }
            asm volatile("" ::: "memory"); }
    }
};
struct EpiOutB {
    static constexpr bool PERM = true, AFTER_DRAIN = false, HOOK = false;
    bf16_t* O;
    __device__ __forceinline__ void operator()(const f32x4 (&acc)[2][2][4][2], const Unit& u, int wr, int wc, int fr, int fq) const {
        const int row0 = u.pm * BM + wr * 64 + fr; const int col0 = u.pn * BM + wc * 32 + 8 * fq;
#pragma unroll
        for (int ai = 0; ai < 2; ++ai)
#pragma unroll
            for (int m = 0; m < 4; ++m) { bf16_t* rowp = O + (size_t)(row0 + ai * HALF + m * 16) * 2048 + col0;
#pragma unroll
                for (int bj = 0; bj < 2; ++bj) { const f32x4 v0 = acc[ai][bj][m][0], v1 = acc[ai][bj][m][1];
                    u32x4 w; w.x = cvt_pk_bf16(v0[0], v0[1]); w.y = cvt_pk_bf16(v0[2], v0[3]); w.z = cvt_pk_bf16(v1[0], v1[1]); w.w = cvt_pk_bf16(v1[2], v1[3]);
                    *(u32x4*)(rowp + bj * HALF) = w; } }
    }
};
template <class Epi, class Sched, bool ALIGN_EPI = false, bool SP2 = false>
__device__ __forceinline__ void gemm_phase(PG8_LAS unsigned char* lds, const Gemm g, const Sched& S, const Epi& E) {
    int tid_ = threadIdx.x; asm volatile("" : "+v"(tid_)); const int tid = tid_, wid = __builtin_amdgcn_readfirstlane(tid >> 6), lane = tid & 63, wr = wid >> 2, wc = wid & 3, fr = lane & 15, fq = lane >> 4;
    const int K = g.ld, nt = g.K / BK;
    unsigned voffA[2], voffB[2];
#pragma unroll
    for (int i = 0; i < 2; ++i) { int R, C; stage_rc(tid * 16 + i * 8192, R, C); const int Rb = Epi::PERM ? ((R & ~31) + perm32(R & 31)) : R;
        voffA[i] = (unsigned)(R * K + C) * 2u; voffB[i] = (unsigned)(Rb * K + C) * 2u; }
    const size_t kstep = (size_t)(BK * 2);
    const size_t hstep = (size_t)HALF * K * 2;
    const size_t tstep = 2 * hstep;
    const unsigned ldsw = (unsigned)wid * 1024u;
    const int aoff = lds_byte(wr * 64 + fr, fq * 8), boff = lds_byte(wc * 32 + fr, fq * 8);
#define PG8_SA(b, h) (((b) * 2 + (h)) * HTB)
#define PG8_SB(b, h) ((4 + (b) * 2 + (h)) * HTB)
#define PG8_STAGE(bufoff, gbase, voff) do { _Pragma("unroll") for (int _i = 0; _i < 2; ++_i) \
        __builtin_amdgcn_global_load_lds((const unsigned*)((const char*)(gbase) + (voff)[_i]), (PG8_LAS unsigned*)(lds + (bufoff) + ldsw + _i * 8192), 16, 0, 0); } while (0)
#define PG8_LDA(dst, b, h) do { _Pragma("unroll") for (int m = 0; m < 4; ++m) _Pragma("unroll") for (int k = 0; k < 2; ++k) dst[m][k] = *(const PG8_LAS bf16x8*)(lds + PG8_SA(b, h) + aoff + m * 2048 + k * 1024); } while (0)
#define PG8_LDB(dst, b, h) do { _Pragma("unroll") for (int n = 0; n < 2; ++n) _Pragma("unroll") for (int k = 0; k < 2; ++k) dst[n][k] = *(const PG8_LAS bf16x8*)(lds + PG8_SB(b, h) + boff + n * 2048 + k * 1024); } while (0)
#define PG8_MMA(ai, bj, At, Bt) do { __builtin_amdgcn_s_setprio(1); _Pragma("unroll") for (int m = 0; m < 4; ++m) _Pragma("unroll") for (int n = 0; n < 2; ++n) _Pragma("unroll") for (int k = 0; k < 2; ++k) \
        acc[ai][bj][m][n] = __builtin_amdgcn_mfma_f32_16x16x32_bf16(Bt[n][k], At[m][k], acc[ai][bj][m][n], 0, 0, 0); __builtin_amdgcn_s_setprio(0); } while (0)
#define PG8_WAIT_V(n) asm volatile("s_waitcnt vmcnt(" #n ")" ::: "memory")
#define PG8_WAIT_L(n) asm volatile("s_waitcnt lgkmcnt(" #n ")" ::: "memory")
#define PG8_BAR __builtin_amdgcn_s_barrier()
#define PG8_SCHED __builtin_amdgcn_sched_barrier(0)
    Unit cur, nxt; int ui = 0;
    if (!S.next(0, cur)) return;
    f32x4 acc[2][2][4][2];
#pragma unroll
    for (int a = 0; a < 2; ++a)
#pragma unroll
        for (int b = 0; b < 2; ++b)
#pragma unroll
            for (int m = 0; m < 4; ++m)
#pragma unroll
                for (int n = 0; n < 2; ++n) acc[a][b][m][n] = (f32x4){0.f, 0.f, 0.f, 0.f};
    bf16x8 At[4][2], B0[2][2], B1[2][2];
    const char* cA = (const char*)g.A + (size_t)cur.pm * tstep; const char* cB = (const char*)g.Bt + (size_t)cur.pn * tstep;
    S.a_ready(cur);
    if constexpr (SP2) {
        PG8_STAGE(PG8_SB(0, 0), cB, voffB); PG8_STAGE(PG8_SB(0, 1), cB + hstep, voffB); PG8_STAGE(PG8_SA(0, 0), cA, voffA); PG8_STAGE(PG8_SA(0, 1), cA + hstep, voffA);
        if (wr == 1) PG8_BAR;
        PG8_WAIT_V(2); PG8_BAR;
        PG8_STAGE(PG8_SB(1, 0), cB + kstep, voffB); PG8_STAGE(PG8_SA(1, 0), cA + kstep, voffA); PG8_STAGE(PG8_SB(1, 1), cB + hstep + kstep, voffB);
        PG8_WAIT_V(6); PG8_BAR;
    } else {
        PG8_STAGE(PG8_SB(0, 0), cB, voffB); PG8_STAGE(PG8_SA(0, 0), cA, voffA); PG8_STAGE(PG8_SB(0, 1), cB + hstep, voffB); PG8_STAGE(PG8_SA(0, 1), cA + hstep, voffA);
        if (wr == 1) PG8_BAR;
        PG8_WAIT_V(4); PG8_BAR;
        PG8_STAGE(PG8_SB(1, 0), cB + kstep, voffB); PG8_STAGE(PG8_SA(1, 0), cA + kstep, voffA); PG8_STAGE(PG8_SB(1, 1), cB + hstep + kstep, voffB);
        PG8_WAIT_V(6); PG8_BAR;
    }
    for (;;) {
        const bool has_next = S.next(ui + 1, nxt);
        const char* nA = has_next ? (const char*)g.A + (size_t)nxt.pm * tstep : cA; const char* nB = has_next ? (const char*)g.Bt + (size_t)nxt.pn * tstep : cB;
        for (int t = 0; t < nt; t += 2) {
            if constexpr (Epi::HOOK) { if (t == E.hook_t) E.hook(acc, cur, wr, wc, fr, fq); }
            const bool last = (t == nt - 2);
            const char* a1 = cA + (size_t)(t + 1) * kstep;
            const char* a2 = last ? nA : cA + (size_t)(t + 2) * kstep; const char* b2 = last ? nB : cB + (size_t)(t + 2) * kstep;
            const char* a3 = a2 + kstep; const char* b3 = b2 + kstep;
            if (last && has_next) S.a_ready(nxt);
            if constexpr (SP2) {
            PG8_LDB(B0, 0, 0); PG8_LDB(B1, 0, 1); PG8_SCHED; PG8_LDA(At, 0, 0); PG8_STAGE(PG8_SA(1, 1), a1 + hstep, voffA);
            PG8_WAIT_V(8); PG8_WAIT_L(0); PG8_BAR; PG8_MMA(0, 0, At, B0); PG8_MMA(0, 1, At, B1); PG8_BAR; PG8_SCHED;
            PG8_LDA(At, 0, 1); PG8_STAGE(PG8_SB(0, 0), b2, voffB); PG8_STAGE(PG8_SB(0, 1), b2 + hstep, voffB); PG8_STAGE(PG8_SA(0, 0), a2, voffA);
            PG8_WAIT_V(8); PG8_WAIT_L(0); PG8_BAR; PG8_MMA(1, 0, At, B0); PG8_MMA(1, 1, At, B1); PG8_BAR; PG8_SCHED;
            PG8_LDB(B0, 1, 0); PG8_LDB(B1, 1, 1); PG8_SCHED; PG8_LDA(At, 1, 0); PG8_STAGE(PG8_SA(0, 1), a2 + hstep, voffA);
            PG8_WAIT_V(8); PG8_WAIT_L(0); PG8_BAR; PG8_MMA(0, 0, At, B0); PG8_MMA(0, 1, At, B1); PG8_BAR; PG8_SCHED;
            PG8_LDA(At, 1, 1); PG8_STAGE(PG8_SB(1, 0), b3, voffB); PG8_STAGE(PG8_SB(1, 1), b3 + hstep, voffB); PG8_STAGE(PG8_SA(1, 0), a3, voffA);
            PG8_WAIT_V(8); PG8_WAIT_L(0); PG8_BAR; PG8_MMA(1, 0, At, B0); PG8_MMA(1, 1, At, B1); PG8_BAR; PG8_SCHED;
            } else {
            PG8_LDB(B0, 0, 0); PG8_SCHED; PG8_LDA(At, 0, 0); PG8_STAGE(PG8_SA(1, 1), a1 + hstep, voffA);
            PG8_WAIT_L(8); PG8_BAR; PG8_WAIT_L(0); PG8_MMA(0, 0, At, B0); PG8_BAR; PG8_SCHED;
            PG8_LDB(B1, 0, 1); PG8_STAGE(PG8_SB(0, 0), b2, voffB);
            PG8_BAR; PG8_WAIT_L(0); PG8_MMA(0, 1, At, B1); PG8_BAR;
            PG8_LDA(At, 0, 1); PG8_STAGE(PG8_SA(0, 0), a2, voffA);
            PG8_BAR; PG8_WAIT_L(0); PG8_MMA(1, 0, At, B0); PG8_BAR; PG8_SCHED;
            PG8_STAGE(PG8_SB(0, 1), b2 + hstep, voffB);
            PG8_WAIT_V(6); PG8_BAR; PG8_MMA(1, 1, At, B1); PG8_BAR;
            PG8_LDB(B0, 1, 0); PG8_SCHED; PG8_LDA(At, 1, 0); PG8_STAGE(PG8_SA(0, 1), a2 + hstep, voffA);
            PG8_WAIT_L(8); PG8_BAR; PG8_WAIT_L(0); PG8_MMA(0, 0, At, B0); PG8_BAR; PG8_SCHED;
            PG8_LDB(B1, 1, 1); PG8_STAGE(PG8_SB(1, 0), b3, voffB);
            PG8_BAR; PG8_WAIT_L(0); PG8_MMA(0, 1, At, B1); PG8_BAR;
            PG8_LDA(At, 1, 1); PG8_STAGE(PG8_SA(1, 0), a3, voffA);
            PG8_BAR; PG8_WAIT_L(0); PG8_MMA(1, 0, At, B0); PG8_BAR; PG8_SCHED;
            PG8_STAGE(PG8_SB(1, 1), b3 + hstep, voffB);
            PG8_WAIT_V(6); PG8_BAR; PG8_MMA(1, 1, At, B1); PG8_BAR;
            }
        }
        if constexpr (ALIGN_EPI) { if (wr == 0) PG8_BAR; }
        if constexpr (!Epi::AFTER_DRAIN) { E(acc, cur, wr, wc, fr, fq); S.done(cur); }
        if (!has_next) break;
#pragma unroll
        for (int a = 0; a < 2; ++a)
#pragma unroll
            for (int b = 0; b < 2; ++b)
#pragma unroll
                for (int m = 0; m < 4; ++m)
#pragma unroll
                    for (int n = 0; n < 2; ++n) acc[a][b][m][n] = (f32x4){0.f, 0.f, 0.f, 0.f};
        cur = nxt; cA = nA; cB = nB; ++ui;
        if constexpr (ALIGN_EPI) { if (wr == 1) PG8_BAR; }
    }
    PG8_WAIT_V(0);
    if constexpr (!ALIGN_EPI) { if (wr == 0) PG8_BAR; }
    PG8_BAR;
    if constexpr (Epi::AFTER_DRAIN) { E.fused(acc, cur, wr, wc, fr, fq, lds, wid, lane); S.done(cur); }
#undef PG8_SA
#undef PG8_SB
#undef PG8_STAGE
#undef PG8_LDA
#undef PG8_LDB
#undef PG8_MMA
#undef PG8_WAIT_V
#undef PG8_WAIT_L
#undef PG8_BAR
#undef PG8_SCHED
}
}

#define LAS __attribute__((address_space(3)))
typedef unsigned short bf16;
typedef unsigned v4u __attribute__((ext_vector_type(4)));
typedef unsigned v2u __attribute__((ext_vector_type(2)));
typedef float f32x4 __attribute__((ext_vector_type(4)));
typedef short bf16x8 __attribute__((ext_vector_type(8)));
constexpr int NWAVES = 8, NTHR = 512;
constexpr int DM = 2048, NP = 8192, NS = 1024, MT = NP + NS;
constexpr int NC = 10240, PW = 1024, LW = 2048;
constexpr int C_UA = 0, C_GA = 1024, C_UB = 2048, C_GB = 4096, C_MA = 6144, C_MB = 8192;
constexpr int NCHUNK = 32;
constexpr float LN_EPS = 1e-5f;
constexpr float DN_ALPHA = 1.41421356237309515f;
constexpr int LDS_MISC = 139264;
constexpr int LDS_JUNK = 131072 + 256;
constexpr int LDS_BYTES = 131072 + 256 + 8192;
constexpr size_t SZ_WIN = (size_t)NC * DM * 2, SZ_WPA = (size_t)DM * PW * 2, SZ_WPB = (size_t)DM * LW * 2, SZ_WOUT = (size_t)DM * DM * 2;
constexpr size_t SZ_POOLW = (size_t)4 * 256 * 256 * 2, SZ_LRUW = (size_t)16 * 128 * 128 * 2;
constexpr size_t WS_WIN = 0;
constexpr size_t WS_WPA = WS_WIN + 2 * SZ_WIN;
constexpr size_t WS_WPB = WS_WPA + 2 * SZ_WPA;
constexpr size_t WS_WOUT = WS_WPB + 2 * SZ_WPB;
constexpr int KCAT = PW + LW;
constexpr size_t WS_WCAT = WS_WPA, SZ_WCAT = (size_t)DM * KCAT * 2;
static_assert(2 * SZ_WCAT == 2 * SZ_WPA + 2 * SZ_WPB, "WCAT overlay");
constexpr size_t WS_POOLW = WS_WOUT + 2 * SZ_WOUT;
constexpr size_t WS_WA = WS_POOLW + 2 * SZ_POOLW;
constexpr size_t WS_WX = WS_WA + 2 * SZ_LRUW;
constexpr size_t WS_C8 = WS_WX + 2 * SZ_LRUW;
constexpr size_t WS_XB = WS_C8 + 2 * 2048 * 4;
constexpr size_t WS_PROJ = WS_XB + (size_t)MT * DM * 2;
constexpr size_t WS_YA = WS_PROJ + (size_t)MT * NC * 2;
constexpr size_t WS_YB = WS_YA + (size_t)MT * PW * 2;
constexpr size_t WS_HL = WS_YB + (size_t)MT * LW * 2;
constexpr size_t WS_PP = WS_HL + (size_t)MT * LW * 4;
constexpr size_t WS_TOT = WS_PP + (size_t)MT * LW * 4;
constexpr size_t WS_TMP = WS_TOT + (size_t)2 * 4 * NCHUNK * LW * 4;
constexpr size_t WS_CTL = WS_TMP + (size_t)MT * DM * 4;
constexpr size_t WS_TOT2 = WS_CTL + 16384;
constexpr size_t WS_PREF2 = WS_TOT2 + (size_t)4 * NCHUNK * LW * 8;
constexpr size_t CTL_BYTES = 16384 + (size_t)4 * NCHUNK * LW * 12;
constexpr size_t WS_END = WS_CTL + CTL_BYTES;
constexpr size_t O_Y = 0;
constexpr size_t O_POOLP = (size_t)MT * DM;
constexpr size_t O_CONVP = O_POOLP + (size_t)2 * 4 * 15 * PW;
constexpr size_t O_HP = O_CONVP + (size_t)2 * 4 * 3 * LW;
constexpr size_t O_POOLS = O_HP + (size_t)2 * 4 * LW;
constexpr size_t O_CONVS = O_POOLS + (size_t)2 * 128 * 15 * PW;
constexpr size_t O_HS = O_CONVS + (size_t)2 * 128 * 3 * LW;
constexpr size_t O_END = O_HS + (size_t)2 * 128 * LW;

#ifndef DUP_P0
#define DUP_P0 0
#endif
#ifndef DUP_G1
#define DUP_G1 0
#endif
#ifndef DUP_MIX
#define DUP_MIX 0
#endif
#ifndef DUP_FIX
#define DUP_FIX 0
#endif
#ifndef DUP_MERGE
#define DUP_MERGE 0
#endif
#ifndef DUP_OUT0
#define DUP_OUT0 0
#endif
struct Params { const float* in[21]; float* out; unsigned char* ws; int ph_lo, ph_hi; };

#define LDS_WAIT() asm volatile("s_waitcnt lgkmcnt(0)" ::: "memory")
__device__ __forceinline__ unsigned f2bf(float f) { unsigned u = __builtin_bit_cast(unsigned, f); return (u + 0x7fffu + ((u >> 16) & 1u)) >> 16; }
__device__ __forceinline__ unsigned pk2(float lo, float hi) { return f2bf(lo) | (f2bf(hi) << 16); }
__device__ __forceinline__ float bflo(unsigned w) { return __uint_as_float(w << 16); }
__device__ __forceinline__ float bfhi(unsigned w) { return __uint_as_float(w & 0xffff0000u); }
__device__ __forceinline__ float wave_sum(float v) {
#pragma unroll
    for (int o = 1; o < 64; o <<= 1) v += __shfl_xor(v, o);
    return v;
}

__device__ __forceinline__ void p0_transpose_item(const float* W, int K, int N, bf16* WT, LAS float* scr, int item, int lane, int ldw = 0, int koff = 0) {
    if (ldw == 0) ldw = K;
    const int nblk = N / 32, kb = item / nblk, nb = item % nblk, k0 = 64 * kb, n0 = 32 * nb;
    float tv_[32];
#pragma unroll
    for (int i = 0; i < 32; ++i) tv_[i] = W[(size_t)(k0 + 2 * i + (lane >> 5)) * N + n0 + (lane & 31)];
#pragma unroll
    for (int i = 0; i < 32; ++i) scr[(2 * i + (lane >> 5)) * 33 + (lane & 31)] = tv_[i];
    LDS_WAIT(); asm volatile("" ::: "memory");
    const int c = lane & 7;
#pragma unroll
    for (int j = 0; j < 4; ++j) { const int n = (lane >> 3) + 8 * j; const LAS float* s = scr + (8 * c) * 33 + n;
        v4u o; o.x = pk2(s[0 * 33], s[1 * 33]); o.y = pk2(s[2 * 33], s[3 * 33]); o.z = pk2(s[4 * 33], s[5 * 33]); o.w = pk2(s[6 * 33], s[7 * 33]);
        *(v4u*)(WT + (size_t)(n0 + n) * ldw + koff + k0 + 8 * c) = o; }
    LDS_WAIT(); asm volatile("" ::: "memory");
}
constexpr int I_IN = (DM / 64) * (NC / 32), I_PA = (PW / 64) * (DM / 32), I_PB = (LW / 64) * (DM / 32), I_OUT = (DM / 64) * (DM / 32);
constexpr int I_PL = 8 * (256 / 64) * (256 / 32), I_LR = 32 * (128 / 64) * (128 / 32);
constexpr int IT_IN = 0, IT_PA = 2 * I_IN, IT_PB = IT_PA + 2 * I_PA, IT_OUT = IT_PB + 2 * I_PB, IT_SMALL = IT_OUT + 2 * I_OUT, IT_END = IT_SMALL + I_PL + 2 * I_LR;
__device__ __forceinline__ void convert_range(LAS unsigned char* lds, const Params& p, const int lo, const int hi, const int gw, const int NGW) {
    int tid_ = threadIdx.x; asm volatile("" : "+v"(tid_)); const int lane = tid_ & 63, wave = tid_ >> 6;
    LAS float* scr = (LAS float*)(lds + wave * 16384);
    unsigned char* ws = p.ws; asm volatile("" : "+s"(ws));
    for (int it = lo + gw; it < hi; it += NGW) {
        int r = it;
        if (r < 2 * I_IN) { const int l = r / I_IN; r -= l * I_IN; p0_transpose_item(p.in[5] + (size_t)l * DM * NC, DM, NC, (bf16*)(ws + WS_WIN + l * SZ_WIN), scr, r, lane); continue; } r -= 2 * I_IN;
        if (r < 2 * I_PA) { const int l = r / I_PA; r -= l * I_PA; p0_transpose_item(p.in[16] + (size_t)l * PW * DM, PW, DM, (bf16*)(ws + WS_WCAT + l * SZ_WCAT), scr, r, lane, KCAT, 0); continue; } r -= 2 * I_PA;
        if (r < 2 * I_PB) { const int l = r / I_PB; r -= l * I_PB; p0_transpose_item(p.in[17] + (size_t)l * LW * DM, LW, DM, (bf16*)(ws + WS_WCAT + l * SZ_WCAT), scr, r, lane, KCAT, PW); continue; } r -= 2 * I_PB;
        if (r < 2 * I_OUT) { const int l = r / I_OUT; r -= l * I_OUT; p0_transpose_item(p.in[18] + (size_t)l * DM * DM, DM, DM, (bf16*)(ws + WS_WOUT + l * SZ_WOUT), scr, r, lane); continue; } r -= 2 * I_OUT;
        if (r < I_PL) { const int mi = r / 32; r -= mi * 32; p0_transpose_item(p.in[7] + (size_t)mi * 65536, 256, 256, (bf16*)(ws + WS_POOLW) + (size_t)mi * 65536, scr, r, lane); continue; } r -= I_PL;
        if (r < I_LR) { const int mi = r / 8; r -= mi * 8; p0_transpose_item(p.in[11] + (size_t)mi * 16384, 128, 128, (bf16*)(ws + WS_WA) + (size_t)mi * 16384, scr, r, lane); continue; } r -= I_LR;
        { const int mi = r / 8; r -= mi * 8; p0_transpose_item(p.in[13] + (size_t)mi * 16384, 128, 128, (bf16*)(ws + WS_WX) + (size_t)mi * 16384, scr, r, lane); }
    }
}
__device__ __forceinline__ void p0_prologue(LAS unsigned char* lds, const Params& p) {
    int tid_ = threadIdx.x; asm volatile("" : "+v"(tid_)); const int tid = tid_, lane = tid & 63, wave = tid >> 6;
    const int gw = blockIdx.x * NWAVES + wave, NGW = gridDim.x * NWAVES;
    unsigned char* ws = p.ws; asm volatile("" : "+s"(ws));
    if (gridDim.x == 256) { convert_range(lds, p, IT_IN, IT_IN + I_IN, gw, NGW); convert_range(lds, p, IT_SMALL, IT_END, gw, NGW); }
    else convert_range(lds, p, 0, IT_END, gw, NGW);
    bf16* XB = (bf16*)(ws + WS_XB);
    for (int m = gw; m < MT; m += NGW) {
        const float* xr = (m < NP) ? p.in[0] + (size_t)m * DM : p.in[1] + (size_t)(m - NP) * DM;
        unsigned long long* o8 = (unsigned long long*)(XB + (size_t)m * DM) + lane;
#pragma unroll
        for (int j = 0; j < 8; ++j) { const f32x4 v = *((const f32x4*)xr + lane + 64 * j); o8[64 * j] = (unsigned long long)pk2(v.x, v.y) | ((unsigned long long)pk2(v.z, v.w) << 32); }
    }
    float* C8 = (float*)(ws + WS_C8);
    for (int i = blockIdx.x * NTHR + tid; i < 2 * LW; i += gridDim.x * NTHR) { const float x = -p.in[15][i]; C8[i] = 8.0f * (fmaxf(x, 0.f) + log1pf(expf(-fabsf(x)))); }
}

__device__ __forceinline__ float mix_sigmoid(float v) { return __builtin_amdgcn_rcpf(1.0f + __expf(-v)); }
__device__ __forceinline__ float one_minus_exp(float x) {
    const float q = 1.f + x * (0.5f + x * (1.f / 6 + x * (1.f / 24 + x * (1.f / 120 + x * (1.f / 720 + x * (1.f / 5040))))));
    return (x > -0.3f) ? -x * q : 1.0f - __expf(x);
}
#define BF8_TO_F32(vw, lo, hi) const f32x4 lo = {bflo(vw.x), bfhi(vw.x), bflo(vw.y), bfhi(vw.y)}, hi = {bflo(vw.z), bfhi(vw.z), bflo(vw.w), bfhi(vw.w)}
#define RLX_AGENT __ATOMIC_RELAXED, __HIP_MEMORY_SCOPE_AGENT
__device__ __forceinline__ int mix_tile_row0(int s) { return s < 128 ? (s & 3) * 2048 + (s >> 2) * 64 : NP + (s - 128) * 64; }
__device__ __forceinline__ void mix_phase(LAS unsigned char* lds, const Params& p, const int layer) {
    int tid_ = threadIdx.x; asm volatile("" : "+v"(tid_)); const int tid = tid_, wid = __builtin_amdgcn_readfirstlane(tid >> 6), lane = tid & 63, fr = lane & 15, fq = lane >> 4;
    unsigned char* ws = p.ws; asm volatile("" : "+s"(ws));
    const bf16* PROJ = (const bf16*)(ws + WS_PROJ);
    float* out = p.out;
    const int G = (int)gridDim.x;
    constexpr int NUA = 288 * 4, NUB = 144 * 16;
    {
        LAS float* XC3 = (LAS float*)lds;
        LAS bf16* At2 = (LAS bf16*)(lds + 3 * 33792);
        LAS float* CWL = (LAS float*)(lds + 3 * 33792 + 2 * 17408);
        const int cw = wid * 16;
        const int q16 = tid & 15, yrow = tid >> 3, yc16 = (tid & 7) * 16;
        bf16x8 ba[4], bx[4]; float bav = 0.f, bxv = 0.f, c8v = 0.f;
        v4u pre[2][4];
#define MIX_PREFETCH_B(uu) do { const int s__ = (uu) >> 4, nb__ = (uu) & 15, r0__ = mix_tile_row0(s__); \
        if (s__ < 128) { _Pragma("unroll") for (int i__ = 0; i__ < 2; ++i__) { const int r__ = r0__ + (tid >> 4) + 32 * i__, t__ = r__ & 2047; const bf16* src__ = PROJ + (size_t)r__ * NC + C_UB + nb__ * 128 + q16 * 8; \
            _Pragma("unroll") for (int k__ = 0; k__ < 4; ++k__) { const int jb__ = 3 - k__; pre[i__][k__] = *(const v4u*)(src__ - ((jb__ <= t__) ? (size_t)jb__ * NC : 0)); } } } } while (0)
        const int u0 = (int)blockIdx.x;
        if (u0 < NUB) {
            const int nb = u0 & 15, c0 = nb * 128, ch = c0 + cw + fr;
            { const bf16* WA = (const bf16*)(ws + WS_WA) + (size_t)(layer * 16 + nb) * 16384 + (size_t)(cw + fr) * 128 + fq * 8;
              const bf16* WX = (const bf16*)(ws + WS_WX) + (size_t)(layer * 16 + nb) * 16384 + (size_t)(cw + fr) * 128 + fq * 8;
#pragma unroll
              for (int ks = 0; ks < 4; ++ks) { ba[ks] = *(const bf16x8*)(WA + ks * 32); bx[ks] = *(const bf16x8*)(WX + ks * 32); }
              bav = p.in[12][layer * LW + ch]; bxv = p.in[14][layer * LW + ch]; c8v = ((const float*)(ws + WS_C8))[layer * LW + ch]; }
            MIX_PREFETCH_B(u0);
            __syncthreads();
            for (int i = tid; i < 5 * 128; i += NTHR) { const int k = i >> 7, cc = i & 127; CWL[i] = (k == 0) ? p.in[10][(size_t)layer * LW + c0 + cc] : p.in[9][((size_t)layer * 4 + (k - 1)) * LW + c0 + cc]; }
            __syncthreads();
            {
                const int r0N = mix_tile_row0(u0 >> 4); const bool prtN = (u0 >> 4) < 128; LAS float* XCN = XC3; LAS bf16* AtN = At2;
            if (prtN) {
                const f32x4 cb0 = *(const LAS f32x4*)(CWL + q16 * 8), cb1 = *(const LAS f32x4*)(CWL + q16 * 8 + 4);
#pragma unroll
                for (int i = 0; i < 2; ++i) {
                    const int rl = (tid >> 4) + 32 * i, t = (r0N + rl) & 2047;
                    f32x4 x0 = cb0, x1 = cb1;
#pragma unroll
                    for (int k = 0; k < 4; ++k) { const float f = ((3 - k) <= t) ? 1.0f : 0.0f;
                        const f32x4 w0 = *(const LAS f32x4*)(CWL + (k + 1) * 128 + q16 * 8), w1 = *(const LAS f32x4*)(CWL + (k + 1) * 128 + q16 * 8 + 4);
                        BF8_TO_F32(pre[i][k], a0, a1); x0 += w0 * (a0 * f); x1 += w1 * (a1 * f); }
                    *(LAS f32x4*)(XCN + rl * 132 + q16 * 8) = x0; *(LAS f32x4*)(XCN + rl * 132 + q16 * 8 + 4) = x1;
                    v4u o; o.x = pk2(x0[0], x0[1]); o.y = pk2(x0[2], x0[3]); o.z = pk2(x1[0], x1[1]); o.w = pk2(x1[2], x1[3]);
                    *(LAS v4u*)(AtN + rl * 136 + q16 * 8) = o;
                }
            } else {
                const float* sconv = p.in[3] + (size_t)layer * 128 * 3 * LW;
#pragma unroll 1
                for (int i = 0; i < 2; ++i) {
                    const int rl = (tid >> 4) + 32 * i, r = r0N + rl, c = c0 + q16 * 8, t = (r - NP) & 7, bs = (r - NP) >> 3;
                    f32x4 x0 = *(const LAS f32x4*)(CWL + q16 * 8), x1 = *(const LAS f32x4*)(CWL + q16 * 8 + 4);
#pragma unroll
                    for (int k = 0; k < 4; ++k) { const int jb = 3 - k;
                        const f32x4 w0 = *(const LAS f32x4*)(CWL + (k + 1) * 128 + q16 * 8), w1 = *(const LAS f32x4*)(CWL + (k + 1) * 128 + q16 * 8 + 4);
                        if (jb <= t) { const v4u vw = *(const v4u*)(PROJ + (size_t)(r - jb) * NC + C_UB + c); BF8_TO_F32(vw, a0, a1); x0 += w0 * a0; x1 += w1 * a1; }
                        else { const float* sp = sconv + ((size_t)bs * 3 + (3 + t - jb)) * LW + c; x0 += w0 * *(const f32x4*)sp; x1 += w1 * *(const f32x4*)(sp + 4); }
                    }
                    *(LAS f32x4*)(XCN + rl * 132 + q16 * 8) = x0; *(LAS f32x4*)(XCN + rl * 132 + q16 * 8 + 4) = x1;
                    v4u o; o.x = pk2(x0[0], x0[1]); o.y = pk2(x0[2], x0[3]); o.z = pk2(x1[0], x1[1]); o.w = pk2(x1[2], x1[3]);
                    *(LAS v4u*)(AtN + rl * 136 + q16 * 8) = o;
                }
            }
            }
            if (u0 + G < NUB) MIX_PREFETCH_B(u0 + G);
            __syncthreads();
            int xb = 0, ab = 0;
            for (int u = u0; u < NUB; u += G) {
                const int s_ = u >> 4, r0 = mix_tile_row0(s_);
                const bool prt = s_ < 128;
                LAS float* XC = XC3 + xb * (33792 / 4); LAS bf16* At = At2 + ab * (17408 / 2);
                const int xbn = (xb == 2) ? 0 : xb + 1, abn = ab ^ 1;
                const v4u sgc0 = *(const v4u*)(PROJ + (size_t)(r0 + yrow) * NC + C_GB + c0 + yc16), sgc1 = *(const v4u*)(PROJ + (size_t)(r0 + yrow) * NC + C_GB + c0 + yc16 + 8);
            f32x4 accr[4], acci[4];
#pragma unroll
            for (int m = 0; m < 4; ++m) { accr[m] = (f32x4){0.f, 0.f, 0.f, 0.f}; acci[m] = (f32x4){0.f, 0.f, 0.f, 0.f}; }
#pragma unroll
            for (int ks = 0; ks < 4; ++ks)
#pragma unroll
                for (int m = 0; m < 4; ++m) { const bf16x8 a = *(const LAS bf16x8*)(At + (m * 16 + fr) * 136 + ks * 32 + fq * 8);
                    accr[m] = __builtin_amdgcn_mfma_f32_16x16x32_bf16(a, ba[ks], accr[m], 0, 0, 0);
                    acci[m] = __builtin_amdgcn_mfma_f32_16x16x32_bf16(a, bx[ks], acci[m], 0, 0, 0); }
            float hl[4][4], pl[4][4];
            float Hc = 0.f, Pc = 1.f;
            const int gq = prt ? fq : (fq & 1);
            float h0s[4] = {0.f, 0.f, 0.f, 0.f};
            if (!prt) {
#pragma unroll
                for (int m = 0; m < 4; ++m) h0s[m] = p.in[4][(size_t)(layer * 128 + ((r0 - NP) >> 3) + 2 * m + (fq >> 1)) * LW + ch];
            }
#pragma unroll
            for (int m = 0; m < 4; ++m) {
                float h_[4], P_[4];
#pragma unroll
                for (int j = 0; j < 4; ++j) { const float xa = XC[(m * 16 + fq * 4 + j) * 132 + cw + fr];
                    const float rg = mix_sigmoid(accr[m][j] + bav), ig = mix_sigmoid(acci[m][j] + bxv), la = -rg * c8v, x2 = 2.0f * la;
                    const float Pj = __expf(la);
                    const float q_ = 1.f + x2 * (0.5f + x2 * (1.f / 6 + x2 * (1.f / 24 + x2 * (1.f / 120 + x2 * (1.f / 720 + x2 * (1.f / 5040))))));
                    const float om = (x2 > -0.3f) ? -x2 * q_ : 1.0f - Pj * Pj;
                    P_[j] = Pj; h_[j] = __builtin_amdgcn_sqrtf(om) * (ig * xa); }
#pragma unroll
                for (int j = 1; j < 4; ++j) { h_[j] = P_[j] * h_[j - 1] + h_[j]; P_[j] = P_[j] * P_[j - 1]; }
                float Pg = P_[3], Hg = h_[3];
                { const float Pu = __shfl_up(Pg, 16), Hu = __shfl_up(Hg, 16); if (gq >= 1) { Hg = Pg * Hu + Hg; Pg = Pg * Pu; } }
                { const float Pu = __shfl_up(Pg, 32), Hu = __shfl_up(Hg, 32); if (gq >= 2) { Hg = Pg * Hu + Hg; Pg = Pg * Pu; } }
                float Pe = __shfl_up(Pg, 16), He = __shfl_up(Hg, 16); if (gq == 0) { Pe = 1.f; He = 0.f; }
                const float Hcm = prt ? Hc : h0s[m];
                const float Hin = Pe * Hcm + He, Pin = Pe * Pc;
#pragma unroll
                for (int j = 0; j < 4; ++j) { hl[m][j] = h_[j] + P_[j] * Hin; pl[m][j] = P_[j] * Pin; }
                const float hb = __shfl(hl[m][3], 48 + fr), pb_ = __shfl(pl[m][3], 48 + fr);
                Hc = prt ? hb : 0.f; Pc = prt ? pb_ : 1.f;
            }
            if (!prt && (fq & 1)) {
#pragma unroll
                for (int m = 0; m < 4; ++m) out[O_HS + (size_t)(layer * 128 + ((r0 - NP) >> 3) + 2 * m + (fq >> 1)) * LW + ch] = hl[m][3];
            }
                if (prt) {
                const int b_ = r0 >> 11, c_ = (r0 & 2047) >> 6;
                const unsigned tag = (unsigned)layer + 1u;
                unsigned long long* T1 = (unsigned long long*)(ws + WS_TOT2) + (size_t)(b_ * 32) * LW + ch;
                unsigned* PF = (unsigned*)(ws + WS_PREF2) + (size_t)(b_ * 32) * LW + ch;
                if (fq == 0) __hip_atomic_store(T1 + (size_t)c_ * LW, ((unsigned long long)__float_as_uint(Hc) << 32) | (unsigned long long)((__float_as_uint(Pc) & ~3u) | tag), RLX_AGENT);
                }
                if (u + G < NUB) {
                    const int r0N = mix_tile_row0((u + G) >> 4); const bool prtN = ((u + G) >> 4) < 128; LAS float* XCN = XC3 + xbn * (33792 / 4); LAS bf16* AtN = At2 + abn * (17408 / 2);
            if (prtN) {
                const f32x4 cb0 = *(const LAS f32x4*)(CWL + q16 * 8), cb1 = *(const LAS f32x4*)(CWL + q16 * 8 + 4);
#pragma unroll
                for (int i = 0; i < 2; ++i) {
                    const int rl = (tid >> 4) + 32 * i, t = (r0N + rl) & 2047;
                    f32x4 x0 = cb0, x1 = cb1;
#pragma unroll
                    for (int k = 0; k < 4; ++k) { const float f = ((3 - k) <= t) ? 1.0f : 0.0f;
                        const f32x4 w0 = *(const LAS f32x4*)(CWL + (k + 1) * 128 + q16 * 8), w1 = *(const LAS f32x4*)(CWL + (k + 1) * 128 + q16 * 8 + 4);
                        BF8_TO_F32(pre[i][k], a0, a1); x0 += w0 * (a0 * f); x1 += w1 * (a1 * f); }
                    *(LAS f32x4*)(XCN + rl * 132 + q16 * 8) = x0; *(LAS f32x4*)(XCN + rl * 132 + q16 * 8 + 4) = x1;
                    v4u o; o.x = pk2(x0[0], x0[1]); o.y = pk2(x0[2], x0[3]); o.z = pk2(x1[0], x1[1]); o.w = pk2(x1[2], x1[3]);
                    *(LAS v4u*)(AtN + rl * 136 + q16 * 8) = o;
                }
            } else {
                const float* sconv = p.in[3] + (size_t)layer * 128 * 3 * LW;
#pragma unroll 1
                for (int i = 0; i < 2; ++i) {
                    const int rl = (tid >> 4) + 32 * i, r = r0N + rl, c = c0 + q16 * 8, t = (r - NP) & 7, bs = (r - NP) >> 3;
                    f32x4 x0 = *(const LAS f32x4*)(CWL + q16 * 8), x1 = *(const LAS f32x4*)(CWL + q16 * 8 + 4);
#pragma unroll
                    for (int k = 0; k < 4; ++k) { const int jb = 3 - k;
                        const f32x4 w0 = *(const LAS f32x4*)(CWL + (k + 1) * 128 + q16 * 8), w1 = *(const LAS f32x4*)(CWL + (k + 1) * 128 + q16 * 8 + 4);
                        if (jb <= t) { const v4u vw = *(const v4u*)(PROJ + (size_t)(r - jb) * NC + C_UB + c); BF8_TO_F32(vw, a0, a1); x0 += w0 * a0; x1 += w1 * a1; }
                        else { const float* sp = sconv + ((size_t)bs * 3 + (3 + t - jb)) * LW + c; x0 += w0 * *(const f32x4*)sp; x1 += w1 * *(const f32x4*)(sp + 4); }
                    }
                    *(LAS f32x4*)(XCN + rl * 132 + q16 * 8) = x0; *(LAS f32x4*)(XCN + rl * 132 + q16 * 8 + 4) = x1;
                    v4u o; o.x = pk2(x0[0], x0[1]); o.y = pk2(x0[2], x0[3]); o.z = pk2(x1[0], x1[1]); o.w = pk2(x1[2], x1[3]);
                    *(LAS v4u*)(AtN + rl * 136 + q16 * 8) = o;
                }
            }
                    if (u + 2 * G < NUB) MIX_PREFETCH_B(u + 2 * G);
                }
                if (prt) {
                const int b_ = r0 >> 11, c_ = (r0 & 2047) >> 6;
                const unsigned tag = (unsigned)layer + 1u;
                unsigned long long* T1 = (unsigned long long*)(ws + WS_TOT2) + (size_t)(b_ * 32) * LW + ch;
                unsigned* PF = (unsigned*)(ws + WS_PREF2) + (size_t)(b_ * 32) * LW + ch;
                float Hin = 0.f;
                if (c_ > 0) {
                    float Pacc = 1.f, Hacc = 0.f; bool done = false;
                    for (int base = 0; !done; base += 4) {
                        const int jc = c_ - 1 - base - fq;
                        unsigned long long w1 = 0ull; unsigned w2 = 0u, spins = 0u; int gstop = 4;
                        for (;;) {
                            bool v1 = true, v2 = true;
                            if (jc >= 0) { w1 = __hip_atomic_load(T1 + (size_t)jc * LW, RLX_AGENT); w2 = __hip_atomic_load(PF + (size_t)jc * LW, RLX_AGENT);
                                v1 = (((unsigned)w1) & 3u) == tag; v2 = (w2 & 3u) == tag; }
                            const unsigned long long m1 = __ballot(v1), m2 = __ballot(v2);
                            bool decided = true; gstop = 4;
#pragma unroll
                            for (int g = 3; g >= 0; --g) {
                                const unsigned s2 = (unsigned)(m2 >> (16 * g)) & 0xFFFFu, s1 = (unsigned)(m1 >> (16 * g)) & 0xFFFFu;
                                if (s2 == 0xFFFFu) { gstop = g; decided = true; } else if (s1 != 0xFFFFu) { gstop = 4; decided = false; }
                            }
                            if (decided || ++spins > (1u << 22)) break;
                        }
                        const float Pv = __uint_as_float(((unsigned)w1) & ~3u), Hv = __uint_as_float((unsigned)(w1 >> 32)), Fv = (jc >= 0) ? __uint_as_float(w2 & ~3u) : 0.f;
#pragma unroll
                        for (int g = 0; g < 4; ++g) {
                            const float Pg_ = __shfl(Pv, 16 * g + fr), Hg_ = __shfl(Hv, 16 * g + fr), Fg_ = __shfl(Fv, 16 * g + fr);
                            if (!done) { if (g == gstop) { Hin = Pacc * Fg_ + Hacc; done = true; } else if (g < gstop) { Hacc = Hacc + Pacc * Hg_; Pacc = Pacc * Pg_; } }
                        }
                        if (spins > (1u << 20)) done = true;
                    }
                }
                const float Hout = Pc * Hin + Hc;
                if (fq == 0) __hip_atomic_store(PF + (size_t)c_ * LW, (__float_as_uint(Hout) & ~3u) | tag, RLX_AGENT);
                if (c_ == 31 && fq == 0) out[O_HP + (size_t)(layer * 4 + b_) * LW + ch] = Hout;
#pragma unroll
                    for (int m = 0; m < 4; ++m)
#pragma unroll
                        for (int jj = 0; jj < 4; ++jj) hl[m][jj] = hl[m][jj] + pl[m][jj] * Hin;
                }
#pragma unroll
                for (int m = 0; m < 4; ++m)
#pragma unroll
                    for (int jj = 0; jj < 4; ++jj) XC[(m * 16 + fq * 4 + jj) * 132 + cw + fr] = hl[m][jj];
                __syncthreads();
            {
                const int row = yrow, c16 = yc16; const size_t r = (size_t)(r0 + row);
                const v4u g0 = sgc0, g1 = sgc1;
                const f32x4 h0 = *(const LAS f32x4*)(XC + row * 132 + c16), h1 = *(const LAS f32x4*)(XC + row * 132 + c16 + 4),
                            h2 = *(const LAS f32x4*)(XC + row * 132 + c16 + 8), h3 = *(const LAS f32x4*)(XC + row * 132 + c16 + 12);
                v4u o0, o1;
                o0.x = pk2(h0[0] * bflo(g0.x), h0[1] * bfhi(g0.x)); o0.y = pk2(h0[2] * bflo(g0.y), h0[3] * bfhi(g0.y)); o0.z = pk2(h1[0] * bflo(g0.z), h1[1] * bfhi(g0.z)); o0.w = pk2(h1[2] * bflo(g0.w), h1[3] * bfhi(g0.w));
                o1.x = pk2(h2[0] * bflo(g1.x), h2[1] * bfhi(g1.x)); o1.y = pk2(h2[2] * bflo(g1.y), h2[3] * bfhi(g1.y)); o1.z = pk2(h3[0] * bflo(g1.z), h3[1] * bfhi(g1.z)); o1.w = pk2(h3[2] * bflo(g1.w), h3[3] * bfhi(g1.w));
                bf16* yp = (bf16*)(ws + WS_YA) + r * KCAT + PW + c0 + c16;
                *(v4u*)yp = o0; *(v4u*)(yp + 8) = o1;
            }
                xb = xbn; ab = abn;
            }
        }
#undef MIX_PREFETCH_B
    }
    __syncthreads();
    {
        LAS float* SL = (LAS float*)lds;
        LAS bf16* At = (LAS bf16*)(lds + 92 * 264 * 4);
        const int q = tid & 31, i0 = tid >> 5;
        int g_cur = -1;
        bf16x8 b[2][8]; f32x4 ps[2];
        v4u vw[3]; v2u sgv[2][2];
#define MIX_PREFETCH_A(uu) do { const int g__ = (uu) & 3, r0__ = ((uu) >> 2) * 32; \
        _Pragma("unroll") for (int n__ = 0; n__ < 2; ++n__) _Pragma("unroll") for (int m__ = 0; m__ < 2; ++m__) \
            sgv[m__][n__] = *(const v2u*)(PROJ + (size_t)(r0__ + m__ * 16 + fr) * NC + C_GA + g__ * 256 + wid * 32 + n__ * 16 + fq * 4); \
        if (r0__ < NP) { const int t0__ = r0__ & 2047; _Pragma("unroll") for (int k__ = 0; k__ < 3; ++k__) { const int i__ = i0 + 16 * k__; const bool ok__ = (i__ < 47) && (t0__ - 15 + i__ >= 0); \
            vw[k__] = *(const v4u*)(PROJ + (size_t)(ok__ ? r0__ - 15 + i__ : r0__) * NC + C_UA + g__ * 256 + q * 8); } } } while (0)
        int ua = (int)blockIdx.x;
        if (ua < NUA) MIX_PREFETCH_A(ua);
        for (; ua < NUA; ua += G) {
            const int tt = ua >> 2, g = ua & 3, r0 = tt * 32, w = 2 << g;
            const bool prt = r0 < NP;
            const int col = g * 256 + q * 8;
            __syncthreads();
            if (g != g_cur) { g_cur = g;
                const bf16* WT = (const bf16*)(ws + WS_POOLW) + (size_t)(layer * 4 + g) * 65536 + (size_t)(wid * 32 + fr) * 256 + fq * 8;
#pragma unroll
                for (int n = 0; n < 2; ++n)
#pragma unroll
                    for (int ks = 0; ks < 8; ++ks) b[n][ks] = *(const bf16x8*)(WT + (size_t)n * 16 * 256 + ks * 32);
#pragma unroll
                for (int n = 0; n < 2; ++n) ps[n] = *(const f32x4*)(p.in[8] + layer * PW + g * 256 + wid * 32 + n * 16 + fq * 4); }
            if (prt) {
                const int t0 = r0 & 2047;
#pragma unroll
                for (int k = 0; k < 3; ++k) { const int i = i0 + 16 * k; const float f = ((i < 47) && (t0 - 15 + i >= 0)) ? 1.0f : 0.0f; BF8_TO_F32(vw[k], a0, a1);
                    if (i < 47) { *(LAS f32x4*)(SL + i * 264 + q * 8) = a0 * f; *(LAS f32x4*)(SL + i * 264 + q * 8 + 4) = a1 * f; } }
            } else {
                const float* spool = p.in[2] + (size_t)layer * 128 * 15 * PW; const int bs0 = (r0 - NP) >> 3;
#pragma unroll 2
                for (int i = tid >> 5; i < 92; i += 16) { const int sq = i / 23, ii = i - sq * 23; f32x4 a0, a1;
                    if (ii < 15) { const float* sp = spool + ((size_t)(bs0 + sq) * 15 + ii) * PW + col; a0 = *(const f32x4*)sp; a1 = *(const f32x4*)(sp + 4); }
                    else { const v4u vv = *(const v4u*)(PROJ + (size_t)(NP + (bs0 + sq) * 8 + (ii - 15)) * NC + C_UA + col); BF8_TO_F32(vv, c0_, c1_); a0 = c0_; a1 = c1_; }
                    *(LAS f32x4*)(SL + i * 264 + q * 8) = a0; *(LAS f32x4*)(SL + i * 264 + q * 8 + 4) = a1; }
            }
            __syncthreads();
            v2u sgc[2][2];
#pragma unroll
            for (int m = 0; m < 2; ++m)
#pragma unroll
                for (int n = 0; n < 2; ++n) sgc[m][n] = sgv[m][n];
            if (ua + G < NUA) MIX_PREFETCH_A(ua + G);
#pragma unroll
            for (int i = 0; i < 2; ++i) {
                const int rl = (tid >> 5) + 16 * i, bi = prt ? rl + 15 : (rl >> 3) * 23 + 15 + (rl & 7), t = (r0 + rl) & 2047;
                const LAS float* sp = SL + bi * 264 + q * 8;
                const f32x4 u0 = *(const LAS f32x4*)sp, u1 = *(const LAS f32x4*)(sp + 4);
                f32x4 s0 = u0, s1 = u1;
#pragma unroll 4
                for (int j = 1; j < w; ++j) { s0 += *(const LAS f32x4*)(sp - j * 264); s1 += *(const LAS f32x4*)(sp - j * 264 + 4); }
                const int cnt = (prt && t + 1 < w) ? t + 1 : w; const float inv = 1.0f / (float)cnt;
                const f32x4 d0 = s0 * inv - u0, d1 = s1 * inv - u1;
                v4u o; o.x = pk2(d0[0], d0[1]); o.y = pk2(d0[2], d0[3]); o.z = pk2(d1[0], d1[1]); o.w = pk2(d1[2], d1[3]);
                *(LAS v4u*)(At + rl * 264 + q * 8) = o;
            }
            __syncthreads();
            f32x4 acc[2][2];
#pragma unroll
            for (int m = 0; m < 2; ++m)
#pragma unroll
                for (int n = 0; n < 2; ++n) acc[m][n] = (f32x4){0.f, 0.f, 0.f, 0.f};
#pragma unroll
            for (int ks = 0; ks < 8; ++ks) {
                bf16x8 a[2];
#pragma unroll
                for (int m = 0; m < 2; ++m) a[m] = *(const LAS bf16x8*)(At + (m * 16 + fr) * 264 + ks * 32 + fq * 8);
#pragma unroll
                for (int m = 0; m < 2; ++m)
#pragma unroll
                    for (int n = 0; n < 2; ++n) acc[m][n] = __builtin_amdgcn_mfma_f32_16x16x32_bf16(b[n][ks], a[m], acc[m][n], 0, 0, 0);
            }
            bf16* YA = (bf16*)(ws + WS_YA);
#pragma unroll
            for (int m = 0; m < 2; ++m)
#pragma unroll
                for (int n = 0; n < 2; ++n) { const int r = r0 + m * 16 + fr, ch = g * 256 + wid * 32 + n * 16 + fq * 4; const v2u sg = sgc[m][n];
                    const f32x4 y = acc[m][n] * ps[n] * (f32x4){bflo(sg.x), bfhi(sg.x), bflo(sg.y), bfhi(sg.y)};
                    v2u o; o.x = pk2(y[0], y[1]); o.y = pk2(y[2], y[3]); *(v2u*)(YA + (size_t)r * KCAT + ch) = o; }
        }
#undef MIX_PREFETCH_A
    }
    const int gt = blockIdx.x * NTHR + tid, GT = gridDim.x * NTHR;
    constexpr int N_PP = 4 * 15 * (PW / 4), N_CP = 4 * 3 * (LW / 4), N_PS = 128 * 15 * (PW / 4), N_CS = 128 * 3 * (LW / 4), N_ST = N_PP + N_CP + N_PS + N_CS;
    for (int it0 = gt; it0 < N_ST; it0 += 3 * GT) {
        const bf16* src[3]; const float* fsrc[3]; float* dst[3]; bool isf[3], ok[3];
#pragma unroll
        for (int k = 0; k < 3; ++k) {
            const int it = it0 + k * GT; ok[k] = it < N_ST; int r = ok[k] ? it : 0; isf[k] = false; src[k] = PROJ; fsrc[k] = p.in[2];
            if (r < N_PP) { const int c4 = r % (PW / 4), i = (r / (PW / 4)) % 15, b_ = r / (15 * (PW / 4));
                src[k] = PROJ + (size_t)(b_ * 2048 + 2033 + i) * NC + C_UA + c4 * 4; dst[k] = out + O_POOLP + ((size_t)(layer * 4 + b_) * 15 + i) * PW + c4 * 4; }
            else if ((r -= N_PP) < N_CP) { const int c4 = r % (LW / 4), i = (r / (LW / 4)) % 3, b_ = r / (3 * (LW / 4));
                src[k] = PROJ + (size_t)(b_ * 2048 + 2045 + i) * NC + C_UB + c4 * 4; dst[k] = out + O_CONVP + ((size_t)(layer * 4 + b_) * 3 + i) * LW + c4 * 4; }
            else if ((r -= N_CP) < N_PS) { const int c4 = r % (PW / 4), i = (r / (PW / 4)) % 15, bs = r / (15 * (PW / 4));
                dst[k] = out + O_POOLS + ((size_t)(layer * 128 + bs) * 15 + i) * PW + c4 * 4;
                if (i < 7) { isf[k] = true; fsrc[k] = p.in[2] + ((size_t)(layer * 128 + bs) * 15 + 8 + i) * PW + c4 * 4; } else src[k] = PROJ + (size_t)(NP + bs * 8 + (i - 7)) * NC + C_UA + c4 * 4; }
            else { r -= N_PS; const int c4 = r % (LW / 4), i = (r / (LW / 4)) % 3, bs = r / (3 * (LW / 4));
                src[k] = PROJ + (size_t)(NP + bs * 8 + 5 + i) * NC + C_UB + c4 * 4; dst[k] = out + O_CONVS + ((size_t)(layer * 128 + bs) * 3 + i) * LW + c4 * 4; }
        }
        v2u wv[3]; f32x4 fv[3];
#pragma unroll
        for (int k = 0; k < 3; ++k) { wv[k] = *(const v2u*)src[k]; fv[k] = *(const f32x4*)fsrc[k]; }
#pragma unroll
        for (int k = 0; k < 3; ++k) { const f32x4 v = isf[k] ? fv[k] : (f32x4){bflo(wv[k].x), bfhi(wv[k].x), bflo(wv[k].y), bfhi(wv[k].y)}; if (ok[k]) *(f32x4*)dst[k] = v; }
    }
}

__device__ __forceinline__ void ln_phase(const Params& p, const int layer, const int row_lo, const int row_hi, const int wg_id, const int n_wg) {
    int tid_ = threadIdx.x; asm volatile("" : "+v"(tid_)); const int tid = tid_, lane = tid & 63, wave = tid >> 6;
    const int gw = wg_id * NWAVES + wave, NGW = n_wg * NWAVES;
    unsigned char* ws = p.ws; asm volatile("" : "+s"(ws)); float* Z = p.out; bf16* XB = (bf16*)(ws + WS_XB);
    const float* g = p.in[19] + layer * DM; const float* bb = p.in[20] + layer * DM;
    const bf16* OB = (const bf16*)(ws + WS_TMP);
    for (int m0 = row_lo + gw; m0 < row_hi; m0 += 2 * NGW) {
        const int m1r = m0 + NGW; const bool ok1 = m1r < row_hi; const int m1 = ok1 ? m1r : m0;
        const v2u* ob0 = (const v2u*)(OB + (size_t)m0 * DM) + lane; const v2u* ob1 = (const v2u*)(OB + (size_t)m1 * DM) + lane;
        f32x4 v0[8], v1[8]; v2u w0[8], w1[8]; float s0 = 0.f, s1 = 0.f;
        if (layer == 0) {
            const f32x4* xr0 = (const f32x4*)((m0 < NP) ? p.in[0] + (size_t)m0 * DM : p.in[1] + (size_t)(m0 - NP) * DM) + lane;
            const f32x4* xr1 = (const f32x4*)((m1 < NP) ? p.in[0] + (size_t)m1 * DM : p.in[1] + (size_t)(m1 - NP) * DM) + lane;
#pragma unroll
            for (int j = 0; j < 8; ++j) { v0[j] = xr0[64 * j]; v1[j] = xr1[64 * j]; w0[j] = ob0[64 * j]; w1[j] = ob1[64 * j]; }
        } else {
            const v2u* xb0 = (const v2u*)(XB + (size_t)m0 * DM) + lane; const v2u* xb1 = (const v2u*)(XB + (size_t)m1 * DM) + lane;
            v2u a0[8], a1[8];
#pragma unroll
            for (int j = 0; j < 8; ++j) { a0[j] = xb0[64 * j]; a1[j] = xb1[64 * j]; w0[j] = ob0[64 * j]; w1[j] = ob1[64 * j]; }
#pragma unroll
            for (int j = 0; j < 8; ++j) { v0[j] = (f32x4){bflo(a0[j].x), bfhi(a0[j].x), bflo(a0[j].y), bfhi(a0[j].y)}; v1[j] = (f32x4){bflo(a1[j].x), bfhi(a1[j].x), bflo(a1[j].y), bfhi(a1[j].y)}; }
        }
#pragma unroll
        for (int j = 0; j < 8; ++j) { v0[j] = v0[j] * DN_ALPHA + (f32x4){bflo(w0[j].x), bfhi(w0[j].x), bflo(w0[j].y), bfhi(w0[j].y)};
            v1[j] = v1[j] * DN_ALPHA + (f32x4){bflo(w1[j].x), bfhi(w1[j].x), bflo(w1[j].y), bfhi(w1[j].y)};
            s0 += (v0[j].x + v0[j].y) + (v0[j].z + v0[j].w); s1 += (v1[j].x + v1[j].y) + (v1[j].z + v1[j].w); }
        const float mean0 = wave_sum(s0) * (1.f / DM), mean1 = wave_sum(s1) * (1.f / DM); float q0 = 0.f, q1 = 0.f;
#pragma unroll
        for (int j = 0; j < 8; ++j) { v0[j] = v0[j] - mean0; v1[j] = v1[j] - mean1;
            q0 += (v0[j].x * v0[j].x + v0[j].y * v0[j].y) + (v0[j].z * v0[j].z + v0[j].w * v0[j].w); q1 += (v1[j].x * v1[j].x + v1[j].y * v1[j].y) + (v1[j].z * v1[j].z + v1[j].w * v1[j].w); }
        const float rstd0 = 1.f / sqrtf(wave_sum(q0) * (1.f / DM) + LN_EPS), rstd1 = 1.f / sqrtf(wave_sum(q1) * (1.f / DM) + LN_EPS);
        f32x4* zr0 = (f32x4*)(Z + (size_t)m0 * DM) + lane; f32x4* zr1 = (f32x4*)(Z + (size_t)m1 * DM) + lane;
        unsigned long long* o80 = (unsigned long long*)(XB + (size_t)m0 * DM) + lane; unsigned long long* o81 = (unsigned long long*)(XB + (size_t)m1 * DM) + lane;
#pragma unroll
        for (int j = 0; j < 8; ++j) { const f32x4 gv = *((const f32x4*)g + lane + 64 * j), bv = *((const f32x4*)bb + lane + 64 * j);
            const f32x4 y0 = v0[j] * rstd0 * gv + bv, y1 = v1[j] * rstd1 * gv + bv;
            if (layer == 0) { o80[64 * j] = (unsigned long long)pk2(y0.x, y0.y) | ((unsigned long long)pk2(y0.z, y0.w) << 32);
                if (ok1) o81[64 * j] = (unsigned long long)pk2(y1.x, y1.y) | ((unsigned long long)pk2(y1.z, y1.w) << 32); }
            else { zr0[64 * j] = y0; if (ok1) zr1[64 * j] = y1; } }
    }
}

#define XB_TMO      128
#define XB_XCNT(j)  (256  + 64 * (j))
#define XB_XSUB(j)  (1280 + 64 * (j))
#define XB_XGEN(j)  (2304 + 64 * (j))
#define XB_TOP      3328
#define XB_TOPGEN   3392
#define XCD_BAR_WORDS 3456
#define XB_SPIN_CAP (1u << 18)

__device__ __forceinline__ unsigned xb_ld(unsigned* p)              { return __hip_atomic_load(p, __ATOMIC_RELAXED, __HIP_MEMORY_SCOPE_AGENT); }
__device__ __forceinline__ unsigned xb_add(unsigned* p, unsigned v) { return __hip_atomic_fetch_add(p, v, __ATOMIC_RELAXED, __HIP_MEMORY_SCOPE_AGENT); }
__device__ __forceinline__ unsigned xb_xcc_id() { return (unsigned)__builtin_amdgcn_s_getreg((3 << 11) | 20) & 0xFu; }
#define XB_SPIN(cond, bar) do { unsigned _sp = 0; while (cond) { __builtin_amdgcn_s_sleep(1); \
    if ((++_sp & 255u) == 0u) { if (xb_ld(&(bar)[XB_TMO])) break; if (_sp > XB_SPIN_CAP) { atomicAdd(&(bar)[XB_TMO], 1u); break; } } } } while (0)

struct XcdBarrier {
    unsigned* bar; unsigned x;
    volatile LAS unsigned* st;
};

__device__ __forceinline__ XcdBarrier xcd_barrier_post(unsigned* bar, volatile LAS unsigned* st) {
    XcdBarrier b; b.bar = bar; b.x = xb_xcc_id(); b.st = st;
    if (threadIdx.x == 0) (void)xb_add(&bar[XB_XCNT(b.x)], 1u);
    return b;
}
__device__ __forceinline__ void xcd_barrier_complete(unsigned* bar, unsigned x, unsigned& nloc, unsigned& nx) {
    const unsigned G = gridDim.x * gridDim.y * gridDim.z;
    unsigned sum, cnt, mine, sp = 0u;
    for (;;) {
        sum = 0u; cnt = 0u; mine = 0u;
#pragma unroll
        for (unsigned j = 0; j < 16; ++j) { const unsigned c = xb_ld(&bar[XB_XCNT(j)]); sum += c; cnt += (c > 0u) ? 1u : 0u; mine = (j == x) ? c : mine; }
        if (sum == G) break;
        __builtin_amdgcn_s_sleep(1);
        if ((++sp & 255u) == 0u) { if (xb_ld(&bar[XB_TMO])) break; if (sp > XB_SPIN_CAP) { atomicAdd(&bar[XB_TMO], 1u); break; } }
    }
    nloc = mine > 0u ? mine : 1u; nx = cnt > 0u ? cnt : 1u;
}

__device__ __forceinline__ void xcd_barrier(const XcdBarrier& b) {
    asm volatile("s_waitcnt vmcnt(0)" ::: "memory");
    __syncthreads();
    if (threadIdx.x == 0) {
        unsigned* bar = b.bar;
        __builtin_amdgcn_s_waitcnt(0);
        unsigned nloc = b.st[0], nx = b.st[1];
        if (nloc == 0u) { xcd_barrier_complete(bar, b.x, nloc, nx); b.st[0] = nloc; b.st[1] = nx; }
        const unsigned old = xb_add(&bar[XB_XSUB(b.x)], 1u);
        const unsigned gen = old / nloc;
        if (old + 1u == (gen + 1u) * nloc) {
            __builtin_amdgcn_fence(__ATOMIC_RELEASE, "agent");
            asm volatile("s_waitcnt vmcnt(0)" ::: "memory");
            const unsigned og = xb_add(&bar[XB_TOP], 1u);
            const unsigned tg = og / nx;
            if (og + 1u == (tg + 1u) * nx) xb_add(&bar[XB_TOPGEN], 1u);
            else XB_SPIN(xb_ld(&bar[XB_TOPGEN]) == tg, bar);
            __builtin_amdgcn_fence(__ATOMIC_ACQUIRE, "agent");
            xb_add(&bar[XB_XGEN(b.x)], 1u);
            asm volatile("s_waitcnt vmcnt(0)" ::: "memory");
        } else {
            XB_SPIN(xb_ld(&bar[XB_XGEN(b.x)]) == gen, bar);
            __builtin_amdgcn_fence(__ATOMIC_ACQUIRE, "agent");
            asm volatile("s_waitcnt vmcnt(0)" ::: "memory");
        }
    }
    __syncthreads();
}

constexpr int W1_EARLY = 1536;
constexpr int LN_EARLY_SPLIT = 24 * 256;
constexpr int LN_EARLY_ROWS = 28 * 256;
struct ListOrder {
    int start, stride, count;
    __device__ __forceinline__ bool next(int i, pg8::Unit& u) const { if (i >= count) return false; const int L = start + i * stride; u.pm = L >> 3; u.pn = L & 7; return true; }
    __device__ __forceinline__ void a_ready(const pg8::Unit&) const {}
    __device__ __forceinline__ void done(const pg8::Unit&) const {}
};
__device__ __forceinline__ int wave_id_l() { int t = threadIdx.x; asm volatile("" : "+v"(t)); return t >> 6; }
__global__ void __launch_bounds__(NTHR, 2) hybrid_fwd(Params p) {
    extern __shared__ __attribute__((aligned(16))) unsigned char lds_raw[];
    LAS unsigned char* lds = (LAS unsigned char*)lds_raw;
    cg::grid_group grid = cg::this_grid();
    volatile LAS unsigned* MISC = (volatile LAS unsigned*)(lds + LDS_MISC);
    if (threadIdx.x < 64) MISC[threadIdx.x] = 0u;
    __syncthreads();
    XcdBarrier bar = xcd_barrier_post((unsigned*)(p.ws + WS_CTL), MISC);
    if (p.ph_lo < 0) grid.sync();
    const int lo = p.ph_lo, hi = p.ph_hi;
#define IN(k) (lo <= (k) && (k) < hi)
#define SEAM(k) do { if (IN(k) && IN((k) + 1)) xcd_barrier(bar); } while (0)
#ifdef EXTRA_SYNCS
    for (int rep = 0; rep < EXTRA_SYNCS; ++rep) xcd_barrier(bar);
#endif
    if (IN(0)) { for (int rep = 0; rep <= DUP_P0; ++rep) p0_prologue(lds, p); }
    SEAM(0);
#pragma unroll 1
    for (int l = 0; l < 2; ++l) {
        const int pb = 1 + 6 * l;
        unsigned char* ws = p.ws; asm volatile("" : "+s"(ws));
        bf16* PROJ = (bf16*)(ws + WS_PROJ);
        if (IN(pb + 0)) {
            pg8::Gemm g{(const bf16*)(ws + WS_XB), (const bf16*)(ws + WS_WIN + l * SZ_WIN), MT, NC, DM, DM};
            pg8::StaticOrder S; S.init(MT, NC, (int)gridDim.x, (int)blockIdx.x);
            pg8::EpiProj E{PROJ, NC, p.in[6] + (size_t)l * 2 * DM};
            for (int rep = 0; rep <= DUP_G1; ++rep) pg8::gemm_phase<pg8::EpiProj, pg8::StaticOrder, true, true>(lds, g, S, E);
            if (gridDim.x == 256 && blockIdx.x >= 160) {
                const int gw = ((int)blockIdx.x - 160) * NWAVES + wave_id_l(), NGW = ((int)gridDim.x - 160) * NWAVES;
                convert_range(lds, p, IT_PA + l * I_PA, IT_PA + (l + 1) * I_PA, gw, NGW); convert_range(lds, p, IT_PB + l * I_PB, IT_PB + (l + 1) * I_PB, gw, NGW);
                convert_range(lds, p, IT_OUT + l * I_OUT, IT_OUT + (l + 1) * I_OUT, gw, NGW);
                if (l == 0) convert_range(lds, p, IT_IN + I_IN, IT_IN + I_IN + W1_EARLY, gw, NGW); }
            else if (l == 1 && gridDim.x != 256 && false) {}
        }
        SEAM(pb + 0);
        if (IN(pb + 1)) { for (int rep = 0; rep <= DUP_MIX; ++rep) mix_phase(lds, p, l); }
        SEAM(pb + 1);
        if (IN(pb + 3)) {
            const int c = (int)blockIdx.x, G = (int)gridDim.x; const bool g256 = (G == 256);
            constexpr int NU = (MT / 256) * (DM / 256);
#pragma unroll 1
            for (int step = 0; step < 3; ++step) {
                ListOrder SM{0, 1, 0}, SO{0, 1, 0};
                const bool split = g256;
                int kh = -1;
                if (split) {
                    if (step == 0) { const int x = c & 7, j = c >> 3; SM = ListOrder{8 * (4 * x + (j & 3)) + (j >> 2), 256, 1}; }
                    else if (step == 1) { if (c < 64) { SM = ListOrder{256 + (c >> 1), 256, 1}; kh = c & 1; }
                                          else { const int cc = c - 64, x = cc & 7, j = cc >> 3; SO = ListOrder{8 * (3 * x + (j % 3)) + (j / 3), 256, 1}; } }
                    else { if (c >= 32 && c < 128) { const int cc = c - 32, x = cc & 7, j = cc >> 3; SO = ListOrder{8 * (24 + 3 * (x >> 1) + (j % 3)) + 4 * (x & 1) + (j / 3), 256, 1}; } }
                } else if (g256) {
                    if (step == 0) SM = ListOrder{c, 256, 1};
                    else if (step == 1) { if (c < 32) SM = ListOrder{256 + c, 256, 1}; else SO = ListOrder{c - 32, 256, 1}; }
                    else { if (c >= 32 && c < 96) SO = ListOrder{224 + (c - 32), 256, 1}; }
                } else {
                    if (step == 0) SM = ListOrder{c, G, c < NU ? (NU - 1 - c) / G + 1 : 0};
                    else if (step == 2) SO = ListOrder{c, G, c < NU ? (NU - 1 - c) / G + 1 : 0};
                }
                if (SM.count) {
                    const int ko = (kh == 1) ? KCAT / 2 : 0;
                    pg8::Gemm g{(const bf16*)(ws + WS_YA) + ko, (const bf16*)(ws + WS_WCAT + l * SZ_WCAT) + ko, MT, DM, (kh >= 0) ? KCAT / 2 : KCAT, KCAT};
                    pg8::EpiMerge E{(kh >= 0) ? (bf16*)(ws + WS_HL) + (size_t)kh * MT * DM : (bf16*)(ws + WS_PP), PROJ, NC, (kh == 1) ? -1 : PW / 64, (kh >= 0) ? 1 : 0};
                    pg8::gemm_phase<pg8::EpiMerge, ListOrder, true, true>(lds, g, SM, E);
                }
                if (SO.count) {
                    pg8::Gemm g{(const bf16*)(ws + WS_PP), (const bf16*)(ws + WS_WOUT + l * SZ_WOUT), MT, DM, DM, DM};
                    pg8::EpiOutB E{(bf16*)(ws + WS_TMP)};
                    pg8::gemm_phase<pg8::EpiOutB, ListOrder, true, true>(lds, g, SO, E);
                }
                if (l == 0 && split && step == 2 && (c < 32 || c >= 128)) {
                    const int gw = (c < 32 ? c : c - 96) * NWAVES + wave_id_l(), NGW = (G - 96) * NWAVES;
                    convert_range(lds, p, IT_IN + I_IN + W1_EARLY, IT_IN + 2 * I_IN, gw, NGW); }
                if (g256 && !split && step == 2 && (c < 32 || c >= 96)) ln_phase(p, l, 0, LN_EARLY_ROWS, c < 32 ? c : c - 64, G - 64);
                if (split && step == 2 && (c < 32 || c >= 128)) ln_phase(p, l, 0, LN_EARLY_SPLIT, c < 32 ? c : c - 96, G - 96);
                if (step < 2) xcd_barrier(bar);
                if (split && step == 1) {
                    const bf16* P0 = (const bf16*)(ws + WS_HL); const bf16* P1 = P0 + (size_t)MT * DM; bf16* MG = (bf16*)(ws + WS_PP);
                    for (int it = c * NTHR + (int)threadIdx.x; it < 1024 * 256; it += G * NTHR) { const size_t r = (size_t)(NP + (it >> 8)); const int c8 = (it & 255) * 8;
                        const v4u a = *(const v4u*)(P0 + r * DM + c8), b = *(const v4u*)(P1 + r * DM + c8), gq = *(const v4u*)(PROJ + r * NC + C_MB + c8);
                        v4u o;
                        o.x = pk2(fmaxf(bflo(gq.x), 1e-30f) * (bflo(a.x) + bflo(b.x)), fmaxf(bfhi(gq.x), 1e-30f) * (bfhi(a.x) + bfhi(b.x)));
                        o.y = pk2(fmaxf(bflo(gq.y), 1e-30f) * (bflo(a.y) + bflo(b.y)), fmaxf(bfhi(gq.y), 1e-30f) * (bfhi(a.y) + bfhi(b.y)));
                        o.z = pk2(fmaxf(bflo(gq.z), 1e-30f) * (bflo(a.z) + bflo(b.z)), fmaxf(bfhi(gq.z), 1e-30f) * (bfhi(a.z) + bfhi(b.z)));
                        o.w = pk2(fmaxf(bflo(gq.w), 1e-30f) * (bflo(a.w) + bflo(b.w)), fmaxf(bfhi(gq.w), 1e-30f) * (bfhi(a.w) + bfhi(b.w)));
                        *(v4u*)(MG + r * DM + c8) = o; }
                    xcd_barrier(bar);
                }
            }
        }
        SEAM(pb + 3);
        if (IN(pb + 5)) ln_phase(p, l, (gridDim.x == 256) ? LN_EARLY_SPLIT : 0, MT, (int)blockIdx.x, (int)gridDim.x);
        if (l == 0) SEAM(pb + 5);
    }
#undef IN
#undef SEAM
}

#ifndef MK_N_LAUNCHES
#define MK_N_LAUNCHES 1
#endif
extern "C" void kernel_launch(void* const* d_in, const int* in_sizes, int n_in, void* d_out, int out_size, void* d_ws, size_t ws_size, hipStream_t stream) {
    static int grid = 0;
    if (grid == 0) {
        if (n_in != 21 || (size_t)out_size != O_END || ws_size < WS_END) { fprintf(stderr, "kernel_launch: unexpected shapes: n_in %d out %d ws %zu (need %zu)\n", n_in, out_size, ws_size, (size_t)WS_END); grid = -1; return; }
        int dev = 0, cus = 0, per_cu = 0;
        if (hipGetDevice(&dev) != hipSuccess || hipDeviceGetAttribute(&cus, hipDeviceAttributeMultiprocessorCount, dev) != hipSuccess) { grid = -1; return; }
        if (hipFuncSetAttribute((const void*)hybrid_fwd, hipFuncAttributeMaxDynamicSharedMemorySize, LDS_BYTES) != hipSuccess) { fprintf(stderr, "kernel_launch: hipFuncSetAttribute failed\n"); grid = -1; return; }
        if (hipOccupancyMaxActiveBlocksPerMultiprocessor(&per_cu, (const void*)hybrid_fwd, NTHR, LDS_BYTES) != hipSuccess || per_cu < 1) { fprintf(stderr, "kernel_launch: occupancy query says %d\n", per_cu); per_cu = 1; }
        (void)hipGetLastError();
        grid = cus - cus % 16;
    }
    if (grid < 0) return;
    Params p{};
    for (int i = 0; i < 21; ++i) p.in[i] = (const float*)d_in[i];
    p.out = (float*)d_out; p.ws = (unsigned char*)d_ws;
    constexpr int NPH = 13;
    if (hipMemsetAsync((char*)d_ws + WS_CTL, 0, CTL_BYTES, stream) != hipSuccess) { fprintf(stderr, "kernel_launch: memset failed\n"); return; }
    if (MK_N_LAUNCHES == 1) {
        p.ph_lo = 0; p.ph_hi = NPH;
        void* args[] = {&p};
        const hipError_t e = hipLaunchCooperativeKernel((const void*)hybrid_fwd, dim3(grid), dim3(NTHR), args, LDS_BYTES, stream);
        if (e != hipSuccess) fprintf(stderr, "kernel_launch: cooperative launch failed: %s (grid %d)\n", hipGetErrorString(e), grid);
    } else {
        for (int ph = 0; ph < NPH; ++ph) { p.ph_lo = ph; p.ph_hi = ph + 1; hipLaunchKernelGGL(hybrid_fwd, dim3(grid), dim3(NTHR), LDS_BYTES, stream, p); }
    }
}
```
